# Optimizing an MI355X kernel written in HIP

```python
import math
import jax
import jax.numpy as jnp
from jax import lax
import numpy as np

D_MODEL = 1024
BATCH = 8
SEQ = 4096
DEPTH = 2

F32 = jnp.float32
EPS = 1e-6
TINY = 1e-30
N_BRANCH = 4
D_BRANCH = D_MODEL // 4

A_HEADS = 4
A_DK = D_BRANCH // A_HEADS
A_DV = D_BRANCH // A_HEADS
A_CHUNK = 64
D_B = D_BRANCH
B_BLOCKS = 4
B_BW = D_B // B_BLOCKS
B_CONV = 4
LRU_C = 8.0
D_C = D_BRANCH
C_ORDER = 2
C_CONV = 3
C_EMB = 33
C_HID = 64
C_MIN_DECAY = math.log(1e-2) / 1.5
C_MAX_DECAY = math.log(1e-2) / 0.3
D_GROUPS = ((128, 1), (512, 4), (2048, 16))
D_HEADS_PER_GROUP = 4
D_HEAD_DIM = D_BRANCH // D_HEADS_PER_GROUP
D_N_HEADS = len(D_GROUPS) * D_HEADS_PER_GROUP
D_QKV = D_N_HEADS * D_HEAD_DIM
N_BUCKETS = 32
MAX_DISTANCE = 1024
NEG_BIG = -1e30
D_FF = -(-8 * D_MODEL // (3 * 256)) * 256
IN_A = 5 * D_BRANCH
IN_B = 2 * D_B
IN_C = 3 * D_C
IN_D = 3 * D_QKV
IN_WIDTH = IN_A + IN_B + IN_C + IN_D
MIXER_OFFSETS = (IN_A, IN_A + IN_B, IN_A + IN_B + IN_C)

kernel_name = "hybrid_gated_hgrn2_rglru_hyena_dilated_encoder"


def rmsnorm(x, g):
    xf = x.astype(F32)
    y = xf * lax.rsqrt(jnp.mean(xf * xf, axis=-1, keepdims=True) + EPS)
    return (y * g.astype(F32)).astype(x.dtype)


def dwconv(x, w, b, left):
    K, C = w.shape
    y = lax.conv_general_dilated(x, w[:, None, :].astype(x.dtype), window_strides=(1,),
                                 padding=[(left, K - 1 - left)],
                                 dimension_numbers=("NWC", "WIO", "NWC"),
                                 feature_group_count=C)
    return y + b.astype(x.dtype)


def hgrn2_bidir(q, f_logit_fwd, f_logit_bwd, v, lb):
    B, S, H, DK = q.shape
    DV = v.shape[-1]
    C = A_CHUNK
    nc = S // C
    lb = lb.astype(F32)

    def forget(fl):
        fl = fl.astype(F32)
        f = lb + (1.0 - lb) * jax.nn.sigmoid(fl)
        log_f = jnp.log(jnp.maximum(f, TINY))
        return log_f, (1.0 - lb) * jax.nn.sigmoid(-fl)

    lf_fwd, k_fwd = forget(f_logit_fwd)
    lf_bwd, k_bwd = forget(f_logit_bwd)
    rev = lambda t: t[:, ::-1]
    qf, vf = q.astype(F32), v.astype(F32)

    def to_chunks(a_fwd, a_bwd):
        t = jnp.stack([a_fwd, rev(a_bwd)])
        return t.reshape(2, B, nc, C, H, t.shape[-1]).transpose(2, 0, 1, 4, 3, 5)

    qs, ks = to_chunks(qf, qf), to_chunks(k_fwd, k_bwd)
    gs, vs = to_chunks(lf_fwd, lf_bwd), to_chunks(vf, vf)
    tril = jnp.tril(jnp.ones((C, C), bool))[:, :, None]

    def step(state, inp):
        qc, kc, gc, vc = inp
        b = jnp.cumsum(gc, axis=-2)
        diff = b[..., :, None, :] - b[..., None, :, :]
        decay = jnp.where(tril, jnp.exp(jnp.where(tril, diff, 0.0)), 0.0)
        scores = jnp.einsum('zbhtk,zbhtsk,zbhsk->zbhts', qc, decay, kc)
        o = (jnp.einsum('zbhts,zbhsv->zbhtv', scores, vc)
             + jnp.einsum('zbhtk,zbhkv->zbhtv', qc * jnp.exp(b), state))
        b_last = b[..., -1:, :]
        state = (state * jnp.exp(b_last)[..., 0, :, None]
                 + jnp.einsum('zbhsk,zbhsv->zbhkv', kc * jnp.exp(b_last - b), vc))
        return state, o

    s0 = jnp.zeros((2, B, H, DK, DV), F32)
    _, o = lax.scan(step, s0, (qs, ks, gs, vs))
    o = o.transpose(1, 2, 0, 4, 3, 5).reshape(2, B, S, H, DV)
    return o[0] + rev(o[1])


def lin_scan(a, u, reverse):
    def comb(e1, e2):
        a1, b1 = e1
        a2, b2 = e2
        return a1 * a2, a2 * b1 + b2
    _, h = lax.associative_scan(comb, (a, u), axis=1, reverse=reverse)
    return h


def rglru_bidir(x, wa, ba, wx, bx, lam):
    B, S, Dr = x.shape
    xf = x.astype(F32)
    xb = xf.reshape(B, S, B_BLOCKS, B_BW)

    def blockdiag(w, b):
        y = jnp.einsum('bsnc,zncd->zbsnd', xb, w.astype(F32)).reshape(2, B, S, Dr)
        return y + b.astype(F32)[:, None, None]

    r = jax.nn.sigmoid(blockdiag(wa, ba))
    ig = jax.nn.sigmoid(blockdiag(wx, bx))
    log_a = -LRU_C * r * jax.nn.softplus(-lam.astype(F32))[:, None, None]
    a = jnp.exp(log_a)
    u = jnp.sqrt(jnp.maximum(-jnp.expm1(2.0 * log_a), 0.0)) * ig * xf[None]
    return lin_scan(a[0], u[0], False) + lin_scan(a[1], u[1], True)


def hyena_filters(L, w1, b1, freq, w2, b2, w3):
    t = jnp.linspace(0.0, 1.0, L, dtype=F32)[:, None]
    bands = (C_EMB - 1) // 2
    w = 2.0 * math.pi * jnp.arange(L, dtype=F32)[:, None] / L
    fr = jnp.linspace(1e-4, bands - 1, bands, dtype=F32)[None]
    z = jnp.concatenate([t, jnp.cos(fr * w), -jnp.sin(fr * w)], axis=-1)
    freq = freq.astype(F32)
    hdn = jnp.sin(freq * (z @ w1.astype(F32) + b1.astype(F32)))
    hdn = jnp.sin(freq * (hdn @ w2.astype(F32) + b2.astype(F32)))
    hf = (hdn @ w3.astype(F32)).reshape(L, C_ORDER, 2, D_C)
    deltas = jnp.linspace(C_MIN_DECAY, C_MAX_DECAY, D_C, dtype=F32)
    hf = hf * jnp.exp(-t * jnp.abs(deltas))[:, None, None, :]
    return hf * lax.rsqrt(jnp.sum(hf * hf, axis=0, keepdims=True) + EPS)


def bidir_fftconv(u, h_fwd, h_bwd, bias):
    L = u.shape[1]
    n = 2 * L
    uf = u.astype(F32)
    U = jnp.fft.rfft(uf, n=n, axis=1)
    H = jnp.fft.rfft(h_fwd, n=n, axis=0) + jnp.conj(jnp.fft.rfft(h_bwd, n=n, axis=0))
    y = jnp.fft.irfft(U * H[None], n=n, axis=1)[:, :L]
    return y + uf * bias.astype(F32)


def t5_bucket(rel):
    half = N_BUCKETS // 2
    max_exact = half // 2
    n = np.abs(rel)
    large = max_exact + (np.log(np.maximum(n, 1) / max_exact) / math.log(MAX_DISTANCE / max_exact)
                         * (half - max_exact)).astype(np.int64)
    large = np.minimum(large, half - 1)
    return (rel > 0).astype(np.int64) * half + np.where(n < max_exact, n, large)


def banded_attention(q, k, v, bias_band, half):
    N, H, n, dh = q.shape
    W = half
    nb = -(-n // W)
    n_pad = nb * W
    qp = jnp.pad(q, ((0, 0), (0, 0), (0, n_pad - n), (0, 0))).reshape(N, H, nb, W, dh)

    def kblocks(t):
        tp = jnp.pad(t, ((0, 0), (0, 0), (W, n_pad - n + W), (0, 0))).reshape(N, H, nb + 2, W, dh)
        return jnp.concatenate([tp[:, :, :-2], tp[:, :, 1:-1], tp[:, :, 2:]], axis=3)

    kb, vb = kblocks(k), kblocks(v)
    a_idx = np.arange(W)[:, None]
    c_idx = np.arange(3 * W)[None, :]
    rel = c_idx - W - a_idx
    key_pos = (np.arange(nb)[:, None, None] - 1) * W + c_idx[None]
    valid = (np.abs(rel) <= W)[None] & (key_pos >= 0) & (key_pos < n)
    bias = bias_band[:, np.clip(rel + W, 0, 2 * W)]
    s = jnp.einsum('zhbqd,zhbkd->zhbqk', qp, kb) * (dh ** -0.5) + bias[:, None]
    s = jnp.where(valid[None, None], s, NEG_BIG)
    m = jnp.max(s, axis=-1, keepdims=True)
    p = jnp.exp(s - m)
    l = jnp.sum(p, axis=-1)
    o = jnp.einsum('zhbqk,zhbkd->zhbqd', p, vb) / l[..., None]
    lse = m[..., 0] + jnp.log(l)
    o = o.reshape(N, H, n_pad, dh)[:, :, :n]
    lse = lse.reshape(N, H, n_pad)[:, :, :n]
    return o, lse


def dilated_attention(q, k, v, rel_bias):
    B, S, _, dh = q.shape
    G = D_HEADS_PER_GROUP
    rel_bias = rel_bias.astype(F32)
    outs, lses = [], []
    for g, (win, dil) in enumerate(D_GROUPS):
        hs = slice(g * G, (g + 1) * G)
        n = S // dil

        def gather(t):
            t = t[:, :, hs].astype(F32).reshape(B, n, dil, G, dh)
            return t.transpose(0, 2, 3, 1, 4).reshape(B * dil, G, n, dh)

        half = win // (2 * dil)
        offsets = np.arange(-half, half + 1) * dil
        bias_band = rel_bias[t5_bucket(offsets)][:, hs].T
        o, lse = banded_attention(gather(q), gather(k), gather(v), bias_band, half)
        outs.append(o.reshape(B, dil, G, n, dh).transpose(0, 3, 1, 2, 4).reshape(B, S, G, dh))
        lses.append(lse.reshape(B, dil, G, n).transpose(0, 3, 1, 2).reshape(B, S, G))
    wts = jax.nn.softmax(jnp.stack(lses), axis=0)
    return jnp.sum(wts[..., None] * jnp.stack(outs), axis=0)


def setup_inputs(seed: int = 0) -> dict:
    key = jax.random.key(seed)
    ks = iter(jax.random.split(key, 40))
    L = DEPTH

    def nrm(shape, scale):
        return scale * jax.random.normal(next(ks), shape, F32)

    lam_u = jax.random.uniform(next(ks), (L, 2, D_B), F32, 0.9, 0.999)
    s = lam_u ** (1.0 / LRU_C)
    lru_lambda = jnp.log(s) - jnp.log1p(-s)
    return {
        "x": nrm((BATCH, SEQ, D_MODEL), 1.0),
        "norm1_g": 1.0 + nrm((L, D_MODEL), 0.01),
        "w_in": nrm((L, D_MODEL, IN_WIDTH), D_MODEL ** -0.5),
        "hgrn_lb_logits": nrm((L, D_BRANCH), 0.5),
        "hgrn_norm_g": 1.0 + nrm((L, D_BRANCH), 0.01),
        "lru_conv_w": nrm((L, B_CONV, D_B), B_CONV ** -0.5),
        "lru_conv_b": nrm((L, D_B), 0.02),
        "lru_wa": nrm((L, 2, B_BLOCKS, B_BW, B_BW), B_BW ** -0.5),
        "lru_ba": nrm((L, 2, D_B), 0.1),
        "lru_wx": nrm((L, 2, B_BLOCKS, B_BW, B_BW), B_BW ** -0.5),
        "lru_bx": nrm((L, 2, D_B), 0.1),
        "lru_lambda": lru_lambda,
        "hy_conv_w": nrm((L, C_CONV, 3 * D_C), C_CONV ** -0.5),
        "hy_conv_b": nrm((L, 3 * D_C), 0.02),
        "hy_w1": nrm((L, C_EMB, C_HID), C_EMB ** -0.5),
        "hy_b1": nrm((L, C_HID), 0.1),
        "hy_freq": 1.0 + nrm((L, C_HID), 0.1),
        "hy_w2": nrm((L, C_HID, C_HID), C_HID ** -0.5),
        "hy_b2": nrm((L, C_HID), 0.1),
        "hy_w3": nrm((L, C_HID, C_ORDER * 2 * D_C), C_HID ** -0.5),
        "hy_bias": nrm((L, C_ORDER, D_C), 0.1),
        "rel_bias": nrm((N_BUCKETS, D_N_HEADS), 0.2),
        "w_branch": nrm((L, N_BRANCH, D_BRANCH, D_MODEL), D_BRANCH ** -0.5),
        "w_gate": nrm((L, D_MODEL, N_BRANCH, D_MODEL), D_MODEL ** -0.5),
        "b_gate": nrm((L, N_BRANCH, D_MODEL), 0.1),
        "w_out": nrm((L, D_MODEL, D_MODEL), D_MODEL ** -0.5),
        "norm2_g": 1.0 + nrm((L, D_MODEL), 0.01),
        "w_ff1": nrm((L, D_MODEL, D_FF), D_MODEL ** -0.5),
        "w_ff3": nrm((L, D_MODEL, D_FF), D_MODEL ** -0.5),
        "w_ff2": nrm((L, D_FF, D_MODEL), D_FF ** -0.5),
        "final_g": 1.0 + nrm((D_MODEL,), 0.01),
    }


def reference(x, norm1_g, w_in, hgrn_lb_logits, hgrn_norm_g, lru_conv_w, lru_conv_b, lru_wa, lru_ba,
              lru_wx, lru_bx, lru_lambda, hy_conv_w, hy_conv_b, hy_w1, hy_b1, hy_freq, hy_w2, hy_b2,
              hy_w3, hy_bias, rel_bias, w_branch, w_gate, b_gate, w_out, norm2_g, w_ff1, w_ff3, w_ff2,
              final_g):
    B, S, _ = x.shape
    lb_soft = jax.nn.softmax(hgrn_lb_logits.astype(F32), axis=0)
    lower_bounds = jnp.cumsum(lb_soft, axis=0) - lb_soft[0]
    for l in range(DEPTH):
        h = rmsnorm(x, norm1_g[l])
        proj = h @ w_in[l]
        pA, pB, pC, pD = jnp.split(proj, MIXER_OFFSETS, axis=-1)

        qA, fA_fwd, fA_bwd, iA, gA = jnp.split(pA, 5, axis=-1)
        heads = lambda t: t.reshape(B, S, A_HEADS, -1)
        oA = hgrn2_bidir(heads(qA), heads(fA_fwd), heads(fA_bwd), heads(iA),
                         lower_bounds[l].reshape(A_HEADS, A_DK))
        oA = rmsnorm(oA, hgrn_norm_g[l].reshape(A_HEADS, A_DV)).reshape(B, S, D_BRANCH)
        yA = (oA * jax.nn.silu(gA.astype(F32))).astype(x.dtype)

        xB, gB = jnp.split(pB, 2, axis=-1)
        xB = dwconv(xB, lru_conv_w[l], lru_conv_b[l], B_CONV // 2)
        hB = rglru_bidir(xB, lru_wa[l], lru_ba[l], lru_wx[l], lru_bx[l], lru_lambda[l])
        yB = (hB * jax.nn.gelu(gB.astype(F32))).astype(x.dtype)

        uC = dwconv(pC, hy_conv_w[l], hy_conv_b[l], C_CONV // 2)
        vC, x1, x2 = jnp.split(uC, 3, axis=-1)
        filt = hyena_filters(S, hy_w1[l], hy_b1[l], hy_freq[l], hy_w2[l], hy_b2[l], hy_w3[l])
        z = x1.astype(F32) * bidir_fftconv(vC, filt[:, 0, 0], filt[:, 0, 1], hy_bias[l, 0])
        yC = (x2.astype(F32) * bidir_fftconv(z, filt[:, 1, 0], filt[:, 1, 1], hy_bias[l, 1])).astype(x.dtype)

        qD, kD, vD = [t.reshape(B, S, D_N_HEADS, D_HEAD_DIM) for t in jnp.split(pD, 3, axis=-1)]
        yD = dilated_attention(qD, kD, vD, rel_bias).reshape(B, S, D_BRANCH).astype(x.dtype)

        mixed = jnp.zeros_like(x)
        for j, y in enumerate((yA, yB, yC, yD)):
            gate = jax.nn.sigmoid(h @ w_gate[l, :, j] + b_gate[l, j])
            mixed = mixed + gate * (y @ w_branch[l, j])
        x = x + mixed @ w_out[l]

        h2 = rmsnorm(x, norm2_g[l])
        x = x + (jax.nn.silu(h2 @ w_ff1[l]) * (h2 @ w_ff3[l])) @ w_ff2[l]
    return rmsnorm(x, final_g)
```

```cpp
#include <hip/hip_runtime.h>
#include <hip/hip_cooperative_groups.h>
#include <cstdio>
#include <cstdint>
namespace cg = cooperative_groups;

#define LAS __attribute__((address_space(3)))
typedef unsigned short bf16_t;
typedef short bf16x8 __attribute__((ext_vector_type(8)));
typedef float f32x4 __attribute__((ext_vector_type(4)));
typedef float f32x16 __attribute__((ext_vector_type(16)));
typedef unsigned u32x4 __attribute__((ext_vector_type(4)));
typedef unsigned u32x2 __attribute__((ext_vector_type(2)));

constexpr int M_TOK = 32768, SEQ = 4096, NB = 8, DM = 1024, DFF = 2816, INW = 4864;
constexpr int NTHR = 512;
#ifndef REP_SYNC
#define REP_SYNC 1
#endif
#ifndef REP_GEMM
#define REP_GEMM 1
#endif
#ifndef REP_MIXA
#define REP_MIXA 1
#endif
#ifndef REP_MIXB
#define REP_MIXB 1
#endif
#ifndef REP_MIXC
#define REP_MIXC 1
#endif
#ifndef REP_HYC
#define REP_HYC 1
#endif
constexpr int LDS_BYTES = 159744;

constexpr size_t SZ_H = (size_t)M_TOK * 1024 * 2;
constexpr size_t OFF_H = 0;
constexpr size_t OFF_R = OFF_H + SZ_H;
constexpr size_t OFF_PROJC = OFF_R;
constexpr size_t OFF_PROJA = OFF_PROJC + (size_t)M_TOK * 768 * 2;
constexpr size_t OFF_PROJB = OFF_PROJA + (size_t)M_TOK * 1280 * 2;
constexpr size_t OFF_PROJD = OFF_PROJB + (size_t)M_TOK * 512 * 2;
constexpr size_t OFF_REND = OFF_PROJD + (size_t)M_TOK * 2304 * 2;
constexpr size_t OFF_YA = OFF_PROJC;
constexpr size_t OFF_YB = OFF_YA + (size_t)M_TOK * 256 * 2;
constexpr size_t OFF_YC = OFF_YB + (size_t)M_TOK * 256 * 2;
constexpr size_t OFF_P = OFF_PROJA;
constexpr size_t OFF_U = OFF_PROJA;
constexpr size_t OFF_UCT = OFF_REND;
constexpr size_t OFF_LSE = OFF_UCT + (size_t)768 * M_TOK * 2;
constexpr size_t OFF_S = OFF_LSE + (size_t)3 * M_TOK * 4 * 4;
constexpr size_t OFF_YD = OFF_S + (size_t)1024 * 4096 * 4;
constexpr size_t OFF_MIXED = OFF_UCT;
constexpr size_t OFF_W = OFF_S + (size_t)2048 * 4096 * 4;
constexpr size_t OFF_WIN = OFF_W;
constexpr size_t OFF_WGATE = OFF_WIN + (size_t)4864 * 1024 * 2;
constexpr size_t OFF_WBR = OFF_WGATE + (size_t)4096 * 1024 * 2;
constexpr size_t OFF_WOUT = OFF_WBR + (size_t)4 * 1024 * 256 * 2;
constexpr size_t OFF_WFF13 = OFF_WOUT + (size_t)1024 * 1024 * 2;
constexpr size_t OFF_WFF2 = OFF_WFF13 + (size_t)5632 * 1024 * 2;
constexpr size_t OFF_HDN = OFF_WFF2 + (size_t)1024 * 2816 * 2;
constexpr size_t OFF_CARA = OFF_HDN + (size_t)4096 * 64 * 4;
constexpr size_t OFF_CARH = OFF_CARA + (size_t)2 * 8 * 64 * 256 * 4;
constexpr size_t OFF_DEC = OFF_CARH + (size_t)2 * 8 * 64 * 256 * 4;
constexpr size_t OFF_BAR = OFF_DEC + (size_t)2048 * 64 * 4;
constexpr size_t OFF_YCT = OFF_BAR + 16384;
constexpr size_t WS_END = OFF_YCT + (size_t)256 * M_TOK * 2;
static_assert(OFF_P + (size_t)M_TOK * 4096 * 2 == OFF_REND, "P fit");
static_assert(WS_END <= (size_t)536870912, "workspace over 512 MiB");

struct Params { const float* in[31]; float* out; unsigned char* ws; };

typedef __bf16 bf2_t __attribute__((ext_vector_type(2)));
typedef float f32x2_t __attribute__((ext_vector_type(2)));
__device__ __forceinline__ unsigned cvt_pk_bf16(float lo, float hi) { f32x2_t v = {lo, hi}; bf2_t r = __builtin_convertvector(v, bf2_t); return __builtin_bit_cast(unsigned, r); }
__device__ __forceinline__ bf16_t f2bf(float f) { return (bf16_t)(cvt_pk_bf16(f, 0.f) & 0xffffu); }
__device__ __forceinline__ float bf2f(bf16_t b) { return __uint_as_float(((unsigned)b) << 16); }
__device__ __forceinline__ float bflo(unsigned u) { return __uint_as_float(u << 16); }
__device__ __forceinline__ float bfhi(unsigned u) { return __uint_as_float(u & 0xffff0000u); }
__device__ __forceinline__ float sigmoidf_(float x) { return 1.0f / (1.0f + __expf(-x)); }
__device__ __forceinline__ float siluf_(float x) { return x * sigmoidf_(x); }
__device__ __forceinline__ float geluf_(float x) { const float y = 0.7978845608028654f * (x + 0.044715f * x * x * x); const float t = 1.0f - 2.0f / (1.0f + __expf(2.0f * y)); return 0.5f * x * (1.0f + t); }
__device__ __forceinline__ float wave_sum(float v) {
#pragma unroll
    for (int o = 1; o < 64; o <<= 1) v += __shfl_xor(v, o);
    return v;
}
typedef short s16x4_t __attribute__((ext_vector_type(4)));
__device__ __forceinline__ s16x4_t lds_tr_b64(const bf16_t* p) { return __builtin_amdgcn_ds_read_tr16_b64_v4i16((LAS s16x4_t*)p); }
__device__ __forceinline__ void wave_lds_fence() { asm volatile("s_waitcnt lgkmcnt(0)" ::: "memory"); __builtin_amdgcn_wave_barrier(); }

#define XB_TMO      128
#define XB_XCNT(j)  (256  + 64 * (j))
#define XB_XSUB(j)  (1280 + 64 * (j))
#define XB_XGEN(j)  (2304 + 64 * (j))
#define XB_TOP      3328
#define XB_TOPGEN   3392
#define XCD_BAR_WORDS 3456
#define XB_SPIN_CAP (1u << 22)
__device__ __forceinline__ unsigned xb_ld(unsigned* p)              { return __hip_atomic_load(p, __ATOMIC_RELAXED, __HIP_MEMORY_SCOPE_AGENT); }
__device__ __forceinline__ unsigned xb_add(unsigned* p, unsigned v) { return __hip_atomic_fetch_add(p, v, __ATOMIC_RELAXED, __HIP_MEMORY_SCOPE_AGENT); }
__device__ __forceinline__ unsigned xb_xcc_id() { return (unsigned)__builtin_amdgcn_s_getreg((3 << 11) | 20) & 0xFu; }
#define XB_SPIN(cond, bar) do { unsigned _sp = 0; while (cond) { __builtin_amdgcn_s_sleep(1); \
    if ((++_sp & 255u) == 0u) { if (xb_ld(&(bar)[XB_TMO])) break; if (_sp > XB_SPIN_CAP) { atomicAdd(&(bar)[XB_TMO], 1u); break; } } } } while (0)
struct XcdBarrier { unsigned* bar; unsigned x; volatile LAS unsigned* st; };
__device__ __forceinline__ XcdBarrier xcd_barrier_post(unsigned* bar, volatile LAS unsigned* st) {
    XcdBarrier b; b.bar = bar; b.x = xb_xcc_id(); b.st = st;
    if (threadIdx.x == 0) (void)xb_add(&bar[XB_XCNT(b.x)], 1u);
    return b;
}
__device__ __forceinline__ void xcd_barrier_complete(unsigned* bar, unsigned x, unsigned& nloc, unsigned& nx) {
    const unsigned G = gridDim.x * gridDim.y * gridDim.z;
    unsigned sum, cnt, mine, sp = 0u;
    for (;;) {
        sum = 0u; cnt = 0u; mine = 0u;
#pragma unroll
        for (unsigned j = 0; j < 16; ++j) { const unsigned c = xb_ld(&bar[XB_XCNT(j)]); sum += c; cnt += (c > 0u) ? 1u : 0u; mine = (j == x) ? c : mine; }
        if (sum == G) break;
        __builtin_amdgcn_s_sleep(1);
        if ((++sp & 255u) == 0u) { if (xb_ld(&bar[XB_TMO])) break; if (sp > XB_SPIN_CAP) { atomicAdd(&bar[XB_TMO], 1u); break; } }
    }
    nloc = mine > 0u ? mine : 1u; nx = cnt > 0u ? cnt : 1u;
}
__device__ __forceinline__ void xcd_barrier(const XcdBarrier& b) {
    asm volatile("s_waitcnt vmcnt(0)" ::: "memory");
    __syncthreads();
    if (threadIdx.x == 0) {
        unsigned* bar = b.bar;
        __builtin_amdgcn_s_waitcnt(0);
        unsigned nloc = b.st[0], nx = b.st[1];
        if (nloc == 0u) { xcd_barrier_complete(bar, b.x, nloc, nx); b.st[0] = nloc; b.st[1] = nx; }
        const unsigned old = xb_add(&bar[XB_XSUB(b.x)], 1u);
        const unsigned gen = old / nloc;
        if (old + 1u == (gen + 1u) * nloc) {
            __builtin_amdgcn_fence(__ATOMIC_RELEASE, "agent");
            asm volatile("s_waitcnt vmcnt(0)" ::: "memory");
            const unsigned og = xb_add(&bar[XB_TOP], 1u);
            const unsigned tg = og / nx;
            if (og + 1u == (tg + 1u) * nx) xb_add(&bar[XB_TOPGEN], 1u);
            else XB_SPIN(xb_ld(&bar[XB_TOPGEN]) == tg, bar);
            __builtin_amdgcn_fence(__ATOMIC_ACQUIRE, "agent");
            xb_add(&bar[XB_XGEN(b.x)], 1u);
            asm volatile("s_waitcnt vmcnt(0)" ::: "memory");
        } else {
            XB_SPIN(xb_ld(&bar[XB_XGEN(b.x)]) == gen, bar);
            __builtin_amdgcn_fence(__ATOMIC_ACQUIRE, "agent");
            asm volatile("s_waitcnt vmcnt(0)" ::: "memory");
        }
    }
    __syncthreads();
}

namespace pg8 {
constexpr int BM = 256, BK = 64, HALF = 128, HTB = HALF * BK * 2, STAGE_BYTES = 8 * HTB, NXCD = 8, WGM = 8;
__host__ __device__ __forceinline__ int lds_byte(int r, int c) { const int st = (r >> 4) * 2 + (c >> 5), rr = r & 15, cc = c & 31, ob = rr * 64 + cc * 2; return st * 1024 + (ob ^ (((ob >> 9) & 1) << 5)); }
__host__ __device__ __forceinline__ void stage_rc(int b, int& R, int& C) { const int st = b / 1024, sb = b % 1024, swz = sb ^ (((sb >> 9) & 1) << 5); R = (st >> 1) * 16 + swz / 64; C = (st & 1) * 32 + (swz % 64) / 2; }
__host__ __device__ __forceinline__ int perm32(int rho) { const int n = rho >> 4, i = rho & 15; return 8 * (i >> 2) + 4 * n + (i & 3); }
struct Unit { int pm, pn; };
struct Gemm { const bf16_t* A; const bf16_t* Bt; int M, N, K; };
struct StaticOrder {
    int nM, nN, nwg, G, c;
    __device__ void init(int M, int N, int G_, int c_) { nM = M / BM; nN = N / BM; nwg = nM * nN; G = G_; c = c_; }
    __device__ bool next(int i, Unit& u) const {
        const long L = (long)i * G + c; if (L >= nwg) return false;
        int wgid = (int)L; { const int q = nwg / NXCD, r = nwg % NXCD, xcd = wgid % NXCD, off = wgid / NXCD; wgid = (xcd < r ? xcd * (q + 1) : r * (q + 1) + (xcd - r) * q) + off; }
        const int nig = WGM * nN, gid = wgid / nig, fm = gid * WGM, gsz = (nM - fm) < WGM ? (nM - fm) : WGM;
        u.pm = fm + ((wgid % nig) % gsz); u.pn = (wgid % nig) / gsz; return true;
    }
};
struct GateOrder {
    int G, c;
    __device__ bool next(int i, Unit& u) const {
        const int su = (i >> 2) * G + c; if (su >= 512) return false;
        u.pm = su >> 2; u.pn = (i & 3) * 4 + (su & 3); return true;
    }
};

template <class Epi, class Sched, bool ALIGN_EPI = false, bool SP2 = false>
__device__ __forceinline__ void gemm_phase(LAS unsigned char* lds, const Gemm g, const Sched& S, const Epi& E) {
    int tid = threadIdx.x; asm volatile("" : "+v"(tid));
    const int wid = __builtin_amdgcn_readfirstlane(tid >> 6), lane = tid & 63, wr = wid >> 2, wc = wid & 3, fr = lane & 15, fq = lane >> 4;
    const int K = g.K, nt = K / BK;
    unsigned voffA[2], voffB[2];
#pragma unroll
    for (int i = 0; i < 2; ++i) { int R, C; stage_rc(tid * 16 + i * 8192, R, C); const int Rb = Epi::PERM ? ((R & ~31) + perm32(R & 31)) : R;
        voffA[i] = (unsigned)(R * K + C) * 2u; voffB[i] = (unsigned)(Rb * K + C) * 2u; }
    const size_t kstep = (size_t)(BK * 2);
    const size_t hstep = (size_t)HALF * K * 2;
    const size_t tstep = 2 * hstep;
    const unsigned ldsw = (unsigned)wid * 1024u;
    const int aoff = lds_byte(wr * 64 + fr, fq * 8), boff = lds_byte(wc * 32 + fr, fq * 8);
#define PG8_SA(b, h) (((b) * 2 + (h)) * HTB)
#define PG8_SB(b, h) ((4 + (b) * 2 + (h)) * HTB)
#define PG8_STAGE(bufoff, gbase, voff) do { _Pragma("unroll") for (int _i = 0; _i < 2; ++_i) \
        __builtin_amdgcn_global_load_lds((const unsigned*)((const char*)(gbase) + (voff)[_i]), (LAS unsigned*)(lds + (bufoff) + ldsw + _i * 8192), 16, 0, 0); } while (0)
#define PG8_LDA(dst, b, h) do { _Pragma("unroll") for (int m = 0; m < 4; ++m) _Pragma("unroll") for (int k = 0; k < 2; ++k) dst[m][k] = *(const LAS bf16x8*)(lds + PG8_SA(b, h) + aoff + m * 2048 + k * 1024); } while (0)
#define PG8_LDB(dst, b, h) do { _Pragma("unroll") for (int n = 0; n < 2; ++n) _Pragma("unroll") for (int k = 0; k < 2; ++k) dst[n][k] = *(const LAS bf16x8*)(lds + PG8_SB(b, h) + boff + n * 2048 + k * 1024); } while (0)
#define PG8_MMA(ai, bj, At, Bt) do { __builtin_amdgcn_s_setprio(1); _Pragma("unroll") for (int m = 0; m < 4; ++m) _Pragma("unroll") for (int n = 0; n < 2; ++n) _Pragma("unroll") for (int k = 0; k < 2; ++k) \
        acc[ai][bj][m][n] = __builtin_amdgcn_mfma_f32_16x16x32_bf16(Bt[n][k], At[m][k], acc[ai][bj][m][n], 0, 0, 0); __builtin_amdgcn_s_setprio(0); } while (0)
#define PG8_WAIT_V(n) asm volatile("s_waitcnt vmcnt(" #n ")" ::: "memory")
#define PG8_WAIT_L(n) asm volatile("s_waitcnt lgkmcnt(" #n ")" ::: "memory")
#define PG8_BAR __builtin_amdgcn_s_barrier()
#define PG8_SCHED __builtin_amdgcn_sched_barrier(0)
    Unit cur, nxt; int ui = 0;
    if (!S.next(0, cur)) return;
    f32x4 acc[2][2][4][2];
#pragma unroll
    for (int a = 0; a < 2; ++a)
#pragma unroll
        for (int b = 0; b < 2; ++b)
#pragma unroll
            for (int m = 0; m < 4; ++m)
#pragma unroll
                for (int n = 0; n < 2; ++n) acc[a][b][m][n] = (f32x4){0.f, 0.f, 0.f, 0.f};
    bf16x8 At[4][2], B0[2][2], B1[2][2];
    const char* cA = (const char*)g.A + (size_t)cur.pm * tstep; const char* cB = (const char*)g.Bt + (size_t)cur.pn * tstep;
    if constexpr (SP2) {
        PG8_STAGE(PG8_SB(0, 0), cB, voffB); PG8_STAGE(PG8_SB(0, 1), cB + hstep, voffB); PG8_STAGE(PG8_SA(0, 0), cA, voffA); PG8_STAGE(PG8_SA(0, 1), cA + hstep, voffA);
        if (wr == 1) PG8_BAR;
        PG8_WAIT_V(2); PG8_BAR;
        PG8_STAGE(PG8_SB(1, 0), cB + kstep, voffB); PG8_STAGE(PG8_SA(1, 0), cA + kstep, voffA); PG8_STAGE(PG8_SB(1, 1), cB + hstep + kstep, voffB);
        PG8_WAIT_V(6); PG8_BAR;
    } else {
        PG8_STAGE(PG8_SB(0, 0), cB, voffB); PG8_STAGE(PG8_SA(0, 0), cA, voffA); PG8_STAGE(PG8_SB(0, 1), cB + hstep, voffB); PG8_STAGE(PG8_SA(0, 1), cA + hstep, voffA);
        if (wr == 1) PG8_BAR;
        PG8_WAIT_V(4); PG8_BAR;
        PG8_STAGE(PG8_SB(1, 0), cB + kstep, voffB); PG8_STAGE(PG8_SA(1, 0), cA + kstep, voffA); PG8_STAGE(PG8_SB(1, 1), cB + hstep + kstep, voffB);
        PG8_WAIT_V(6); PG8_BAR;
    }
    for (;;) {
        const bool has_next = S.next(ui + 1, nxt);
        const char* nA = has_next ? (const char*)g.A + (size_t)nxt.pm * tstep : cA; const char* nB = has_next ? (const char*)g.Bt + (size_t)nxt.pn * tstep : cB;
        for (int t = 0; t < nt; t += 2) {
            const bool last = (t == nt - 2);
            const char* a1 = cA + (size_t)(t + 1) * kstep;
            const char* a2 = last ? nA : cA + (size_t)(t + 2) * kstep; const char* b2 = last ? nB : cB + (size_t)(t + 2) * kstep;
            const char* a3 = a2 + kstep; const char* b3 = b2 + kstep;
            if constexpr (SP2) {
            PG8_LDB(B0, 0, 0); PG8_LDB(B1, 0, 1); PG8_SCHED; PG8_LDA(At, 0, 0); PG8_STAGE(PG8_SA(1, 1), a1 + hstep, voffA);
            PG8_WAIT_V(8); PG8_WAIT_L(0); PG8_BAR; PG8_MMA(0, 0, At, B0); PG8_MMA(0, 1, At, B1); PG8_BAR; PG8_SCHED;
            PG8_LDA(At, 0, 1); PG8_STAGE(PG8_SB(0, 0), b2, voffB); PG8_STAGE(PG8_SB(0, 1), b2 + hstep, voffB); PG8_STAGE(PG8_SA(0, 0), a2, voffA);
            PG8_WAIT_V(8); PG8_WAIT_L(0); PG8_BAR; PG8_MMA(1, 0, At, B0); PG8_MMA(1, 1, At, B1); PG8_BAR; PG8_SCHED;
            PG8_LDB(B0, 1, 0); PG8_LDB(B1, 1, 1); PG8_SCHED; PG8_LDA(At, 1, 0); PG8_STAGE(PG8_SA(0, 1), a2 + hstep, voffA);
            PG8_WAIT_V(8); PG8_WAIT_L(0); PG8_BAR; PG8_MMA(0, 0, At, B0); PG8_MMA(0, 1, At, B1); PG8_BAR; PG8_SCHED;
            PG8_LDA(At, 1, 1); PG8_STAGE(PG8_SB(1, 0), b3, voffB); PG8_STAGE(PG8_SB(1, 1), b3 + hstep, voffB); PG8_STAGE(PG8_SA(1, 0), a3, voffA);
            PG8_WAIT_V(8); PG8_WAIT_L(0); PG8_BAR; PG8_MMA(1, 0, At, B0); PG8_MMA(1, 1, At, B1); PG8_BAR; PG8_SCHED;
            } else {
            PG8_LDB(B0, 0, 0); PG8_SCHED; PG8_LDA(At, 0, 0); PG8_STAGE(PG8_SA(1, 1), a1 + hstep, voffA);
            PG8_WAIT_L(8); PG8_BAR; PG8_WAIT_L(0); PG8_MMA(0, 0, At, B0); PG8_BAR; PG8_SCHED;
            PG8_LDB(B1, 0, 1); PG8_STAGE(PG8_SB(0, 0), b2, voffB);
            PG8_BAR; PG8_WAIT_L(0); PG8_MMA(0, 1, At, B1); PG8_BAR;
            PG8_LDA(At, 0, 1); PG8_STAGE(PG8_SA(0, 0), a2, voffA);
            PG8_BAR; PG8_WAIT_L(0); PG8_MMA(1, 0, At, B0); PG8_BAR; PG8_SCHED;
            PG8_STAGE(PG8_SB(0, 1), b2 + hstep, voffB);
            PG8_WAIT_V(6); PG8_BAR; PG8_MMA(1, 1, At, B1); PG8_BAR;
            PG8_LDB(B0, 1, 0); PG8_SCHED; PG8_LDA(At, 1, 0); PG8_STAGE(PG8_SA(0, 1), a2 + hstep, voffA);
            PG8_WAIT_L(8); PG8_BAR; PG8_WAIT_L(0); PG8_MMA(0, 0, At, B0); PG8_BAR; PG8_SCHED;
            PG8_LDB(B1, 1, 1); PG8_STAGE(PG8_SB(1, 0), b3, voffB);
            PG8_BAR; PG8_WAIT_L(0); PG8_MMA(0, 1, At, B1); PG8_BAR;
            PG8_LDA(At, 1, 1); PG8_STAGE(PG8_SA(1, 0), a3, voffA);
            PG8_BAR; PG8_WAIT_L(0); PG8_MMA(1, 0, At, B0); PG8_BAR; PG8_SCHED;
            PG8_STAGE(PG8_SB(1, 1), b3 + hstep, voffB);
            PG8_WAIT_V(6); PG8_BAR; PG8_MMA(1, 1, At, B1); PG8_BAR;
            }
        }
        if constexpr (ALIGN_EPI) { if (wr == 0) PG8_BAR; }
        E(acc, cur, wr, wc, fr, fq);
        if (!has_next) break;
#pragma unroll
        for (int a = 0; a < 2; ++a)
#pragma unroll
            for (int b = 0; b < 2; ++b)
#pragma unroll
                for (int m = 0; m < 4; ++m)
#pragma unroll
                    for (int n = 0; n < 2; ++n) acc[a][b][m][n] = (f32x4){0.f, 0.f, 0.f, 0.f};
        cur = nxt; cA = nA; cB = nB; ++ui;
        if constexpr (ALIGN_EPI) { if (wr == 1) PG8_BAR; }
    }
    PG8_WAIT_V(0);
    if constexpr (!ALIGN_EPI) { if (wr == 0) PG8_BAR; }
    PG8_BAR;
#undef PG8_SA
#undef PG8_SB
#undef PG8_STAGE
#undef PG8_LDA
#undef PG8_LDB
#undef PG8_MMA
#undef PG8_WAIT_V
#undef PG8_WAIT_L
#undef PG8_BAR
#undef PG8_SCHED
}

struct EpiProj {
    static constexpr bool PERM = true;
    bf16_t *pa, *pb, *pc, *pd;
    __device__ __forceinline__ void operator()(const f32x4 (&acc)[2][2][4][2], const Unit& u, int wr, int wc, int fr, int fq) const {
        bf16_t* base; int ld, c0;
        if (u.pn < 5) { base = pa; ld = 1280; c0 = 256 * u.pn; } else if (u.pn < 7) { base = pb; ld = 512; c0 = 256 * (u.pn - 5); }
        else if (u.pn < 10) { base = pc; ld = 768; c0 = 256 * (u.pn - 7); } else { base = pd; ld = 2304; c0 = 256 * (u.pn - 10); }
        const int row0 = u.pm * BM + wr * 64 + fr, col0 = c0 + wc * 32 + 8 * fq;
#pragma unroll
        for (int ai = 0; ai < 2; ++ai)
#pragma unroll
            for (int m = 0; m < 4; ++m) { bf16_t* rowp = base + (size_t)(row0 + ai * HALF + m * 16) * ld + col0;
#pragma unroll
                for (int bj = 0; bj < 2; ++bj) { const f32x4 v0 = acc[ai][bj][m][0], v1 = acc[ai][bj][m][1];
                    u32x4 w; w.x = cvt_pk_bf16(v0[0], v0[1]); w.y = cvt_pk_bf16(v0[2], v0[3]); w.z = cvt_pk_bf16(v1[0], v1[1]); w.w = cvt_pk_bf16(v1[2], v1[3]);
                    *(u32x4*)(rowp + bj * HALF) = w; } }
    }
};
struct EpiBf16 {
    static constexpr bool PERM = true;
    bf16_t* O; int ldc;
    __device__ __forceinline__ void operator()(const f32x4 (&acc)[2][2][4][2], const Unit& u, int wr, int wc, int fr, int fq) const {
        const int row0 = u.pm * BM + wr * 64 + fr, col0 = u.pn * BM + wc * 32 + 8 * fq;
#pragma unroll
        for (int ai = 0; ai < 2; ++ai)
#pragma unroll
            for (int m = 0; m < 4; ++m) { bf16_t* rowp = O + (size_t)(row0 + ai * HALF + m * 16) * ldc + col0;
#pragma unroll
                for (int bj = 0; bj < 2; ++bj) { const f32x4 v0 = acc[ai][bj][m][0], v1 = acc[ai][bj][m][1];
                    u32x4 w; w.x = cvt_pk_bf16(v0[0], v0[1]); w.y = cvt_pk_bf16(v0[2], v0[3]); w.z = cvt_pk_bf16(v1[0], v1[1]); w.w = cvt_pk_bf16(v1[2], v1[3]);
                    *(u32x4*)(rowp + bj * HALF) = w; } }
    }
};
struct EpiGate {
    static constexpr bool PERM = true;
    const bf16_t* P; bf16_t* mixed; const float* bg;
    __device__ __forceinline__ void operator()(const f32x4 (&acc)[2][2][4][2], const Unit& u, int wr, int wc, int fr, int fq) const {
        const int j = u.pn >> 2, ct = u.pn & 3;
        const int row0 = u.pm * BM + wr * 64 + fr, colg = u.pn * BM + wc * 32 + 8 * fq, colm = ct * BM + wc * 32 + 8 * fq;
        f32x4 bv[2][2];
#pragma unroll
        for (int bj = 0; bj < 2; ++bj)
#pragma unroll
            for (int n = 0; n < 2; ++n) bv[bj][n] = *(const f32x4*)(bg + colg + bj * HALF + 4 * n);
#pragma unroll
        for (int ai = 0; ai < 2; ++ai)
#pragma unroll
            for (int m2 = 0; m2 < 2; ++m2) {
                u32x4 pvv[2][2], ovv[2][2];
#pragma unroll
                for (int mm = 0; mm < 2; ++mm) { const size_t row = (size_t)(row0 + ai * HALF + (2 * m2 + mm) * 16);
#pragma unroll
                    for (int bj = 0; bj < 2; ++bj) { pvv[mm][bj] = *(const u32x4*)(P + row * 4096 + colg + bj * HALF);
                        if (j > 0) ovv[mm][bj] = *(const u32x4*)(mixed + row * 1024 + colm + bj * HALF); else ovv[mm][bj] = (u32x4){0u, 0u, 0u, 0u}; } }
#pragma unroll
                for (int mm = 0; mm < 2; ++mm) { const int m = 2 * m2 + mm; const size_t row = (size_t)(row0 + ai * HALF + m * 16);
#pragma unroll
                    for (int bj = 0; bj < 2; ++bj) {
                        const u32x4 pv = pvv[mm][bj], ov = ovv[mm][bj];
                        bf16_t* mp = mixed + row * 1024 + colm + bj * HALF;
                        const f32x4 a0 = acc[ai][bj][m][0] + bv[bj][0], a1 = acc[ai][bj][m][1] + bv[bj][1];
                        float r[8];
                        r[0] = sigmoidf_(a0[0]) * bflo(pv.x); r[1] = sigmoidf_(a0[1]) * bfhi(pv.x); r[2] = sigmoidf_(a0[2]) * bflo(pv.y); r[3] = sigmoidf_(a0[3]) * bfhi(pv.y);
                        r[4] = sigmoidf_(a1[0]) * bflo(pv.z); r[5] = sigmoidf_(a1[1]) * bfhi(pv.z); r[6] = sigmoidf_(a1[2]) * bflo(pv.w); r[7] = sigmoidf_(a1[3]) * bfhi(pv.w);
                        r[0] += bflo(ov.x); r[1] += bfhi(ov.x); r[2] += bflo(ov.y); r[3] += bfhi(ov.y); r[4] += bflo(ov.z); r[5] += bfhi(ov.z); r[6] += bflo(ov.w); r[7] += bfhi(ov.w);
                        u32x4 w; w.x = cvt_pk_bf16(r[0], r[1]); w.y = cvt_pk_bf16(r[2], r[3]); w.z = cvt_pk_bf16(r[4], r[5]); w.w = cvt_pk_bf16(r[6], r[7]);
                        *(u32x4*)mp = w; } }
                asm volatile("" ::: "memory");
            }
    }
};
struct EpiRes {
    static constexpr bool PERM = false;
    const float* xin; float* out;
    __device__ __forceinline__ void operator()(const f32x4 (&acc)[2][2][4][2], const Unit& u, int wr, int wc, int fr, int fq) const {
        const int row0 = u.pm * BM + wr * 64 + fr, col0 = u.pn * BM + wc * 32 + 4 * fq;
#pragma unroll
        for (int ai = 0; ai < 2; ++ai)
#pragma unroll
            for (int m2 = 0; m2 < 2; ++m2) {
                f32x4 xv[2][2][2];
#pragma unroll
                for (int mm = 0; mm < 2; ++mm) { const size_t off = (size_t)(row0 + ai * HALF + (2 * m2 + mm) * 16) * 1024 + col0;
#pragma unroll
                    for (int bj = 0; bj < 2; ++bj)
#pragma unroll
                        for (int n = 0; n < 2; ++n) xv[mm][bj][n] = *(const f32x4*)(xin + off + bj * HALF + n * 16); }
#pragma unroll
                for (int mm = 0; mm < 2; ++mm) { const size_t off = (size_t)(row0 + ai * HALF + (2 * m2 + mm) * 16) * 1024 + col0;
#pragma unroll
                    for (int bj = 0; bj < 2; ++bj)
#pragma unroll
                        for (int n = 0; n < 2; ++n) *(f32x4*)(out + off + bj * HALF + n * 16) = xv[mm][bj][n] + acc[ai][bj][2 * m2 + mm][n]; }
                asm volatile("" ::: "memory");
            }
    }
};
struct EpiSwiglu {
    static constexpr bool PERM = true;
    bf16_t* U;
    __device__ __forceinline__ void operator()(const f32x4 (&acc)[2][2][4][2], const Unit& u, int wr, int wc, int fr, int fq) const {
        const int row0 = u.pm * BM + wr * 64 + fr, col0 = u.pn * HALF + wc * 32 + 8 * fq;
#pragma unroll
        for (int ai = 0; ai < 2; ++ai)
#pragma unroll
            for (int m = 0; m < 4; ++m) { bf16_t* rowp = U + (size_t)(row0 + ai * HALF + m * 16) * DFF + col0;
                const f32x4 g0 = acc[ai][0][m][0], g1 = acc[ai][0][m][1], h0 = acc[ai][1][m][0], h1 = acc[ai][1][m][1];
                u32x4 w; w.x = cvt_pk_bf16(siluf_(g0[0]) * h0[0], siluf_(g0[1]) * h0[1]); w.y = cvt_pk_bf16(siluf_(g0[2]) * h0[2], siluf_(g0[3]) * h0[3]);
                w.z = cvt_pk_bf16(siluf_(g1[0]) * h1[0], siluf_(g1[1]) * h1[1]); w.w = cvt_pk_bf16(siluf_(g1[2]) * h1[2], siluf_(g1[3]) * h1[3]);
                *(u32x4*)rowp = w; }
    }
};
}

struct Ctx {
    const Params* P; float* out; unsigned char* ws;
    int tid, lane, wave, bid, G;
    unsigned char* lds;
    __device__ __forceinline__ bf16_t* bfp(size_t off) const { return (bf16_t*)(ws + off); }
    __device__ __forceinline__ float* fp(size_t off) const { return (float*)(ws + off); }
};

__device__ __forceinline__ void tr_tile(const float* W, int N, int k0, int n0, bf16_t* WT, int ldt, int drow0, float* scr, int lane) {
#pragma unroll 8
    for (int i = 0; i < 32; ++i) { const int kk = 2 * i + (lane >> 5); scr[kk * 33 + (lane & 31)] = W[(size_t)(k0 + kk) * N + n0 + (lane & 31)]; }
    wave_lds_fence();
    const int c = lane & 7;
#pragma unroll
    for (int j = 0; j < 4; ++j) { const int n = (lane >> 3) + 8 * j; const float* s = scr + (8 * c) * 33 + n;
        u32x4 o; o.x = cvt_pk_bf16(s[0 * 33], s[1 * 33]); o.y = cvt_pk_bf16(s[2 * 33], s[3 * 33]); o.z = cvt_pk_bf16(s[4 * 33], s[5 * 33]); o.w = cvt_pk_bf16(s[6 * 33], s[7 * 33]);
        *(u32x4*)(WT + (size_t)(drow0 + n) * ldt + k0 + 8 * c) = o; }
    wave_lds_fence();
}
__device__ __forceinline__ void rms_row_bf16(const float* xrow, const float* g, bf16_t* orow, int lane) {
    const f32x4* xr = (const f32x4*)xrow + lane; const f32x4* gr = (const f32x4*)g + lane;
    f32x4 v[4]; float s = 0.f;
#pragma unroll
    for (int j = 0; j < 4; ++j) { v[j] = xr[64 * j]; s += (v[j].x * v[j].x + v[j].y * v[j].y) + (v[j].z * v[j].z + v[j].w * v[j].w); }
    const float r = rsqrtf(wave_sum(s) * (1.f / 1024.f) + 1e-6f);
    u32x2* o8 = (u32x2*)orow + lane;
#pragma unroll
    for (int j = 0; j < 4; ++j) { const f32x4 gg = gr[64 * j]; u32x2 o; o.x = cvt_pk_bf16(v[j].x * r * gg.x, v[j].y * r * gg.y); o.y = cvt_pk_bf16(v[j].z * r * gg.z, v[j].w * r * gg.w); o8[64 * j] = o; }
}
__device__ __forceinline__ void rms_row2_bf16(const float* xrow, size_t stride, const float* g, bf16_t* orow, int lane) {
    const f32x4* xr0 = (const f32x4*)xrow + lane; const f32x4* xr1 = (const f32x4*)(xrow + stride) + lane; const f32x4* gr = (const f32x4*)g + lane;
    f32x4 v0[4], v1[4]; float s0 = 0.f, s1 = 0.f;
#pragma unroll
    for (int j = 0; j < 4; ++j) { v0[j] = xr0[64 * j]; v1[j] = xr1[64 * j]; }
#pragma unroll
    for (int j = 0; j < 4; ++j) { s0 += (v0[j].x * v0[j].x + v0[j].y * v0[j].y) + (v0[j].z * v0[j].z + v0[j].w * v0[j].w); s1 += (v1[j].x * v1[j].x + v1[j].y * v1[j].y) + (v1[j].z * v1[j].z + v1[j].w * v1[j].w); }
    const float r0 = rsqrtf(wave_sum(s0) * (1.f / 1024.f) + 1e-6f), r1 = rsqrtf(wave_sum(s1) * (1.f / 1024.f) + 1e-6f);
    u32x2* o0 = (u32x2*)orow + lane; u32x2* o1 = (u32x2*)(orow + stride) + lane;
#pragma unroll
    for (int j = 0; j < 4; ++j) { const f32x4 gg = gr[64 * j]; u32x2 o; o.x = cvt_pk_bf16(v0[j].x * r0 * gg.x, v0[j].y * r0 * gg.y); o.y = cvt_pk_bf16(v0[j].z * r0 * gg.z, v0[j].w * r0 * gg.w); o0[64 * j] = o;
        u32x2 q; q.x = cvt_pk_bf16(v1[j].x * r1 * gg.x, v1[j].y * r1 * gg.y); q.y = cvt_pk_bf16(v1[j].z * r1 * gg.z, v1[j].w * r1 * gg.w); o1[64 * j] = q; }
}
__device__ __forceinline__ void rms_row_f32(float* xrow, const float* g, int lane) {
    f32x4* xr = (f32x4*)xrow + lane; const f32x4* gr = (const f32x4*)g + lane;
    f32x4 v[4]; float s = 0.f;
#pragma unroll
    for (int j = 0; j < 4; ++j) { v[j] = xr[64 * j]; s += (v[j].x * v[j].x + v[j].y * v[j].y) + (v[j].z * v[j].z + v[j].w * v[j].w); }
    const float r = rsqrtf(wave_sum(s) * (1.f / 1024.f) + 1e-6f);
#pragma unroll
    for (int j = 0; j < 4; ++j) { const f32x4 gg = gr[64 * j]; xr[64 * j] = v[j] * r * gg; }
}
__device__ __forceinline__ void hy_hdn_row(const float* w1, const float* b1, const float* fq, const float* w2, const float* b2, float* hdn2, int t, int lane) {
    const float zt = (float)t / 4095.f;
    const float w = 6.283185307179586f * (float)t / 4096.f;
    float pre = b1[lane] + zt * w1[lane];
    float w1c[16], w1s[16];
#pragma unroll
    for (int m = 0; m < 16; ++m) { w1c[m] = w1[(1 + m) * 64 + lane]; w1s[m] = w1[(17 + m) * 64 + lane]; }
#pragma unroll
    for (int m = 0; m < 16; ++m) { const float fr = 1e-4f + (float)m * ((15.f - 1e-4f) / 15.f); const float ang = fr * w;
        pre += cosf(ang) * w1c[m] - sinf(ang) * w1s[m]; }
    const float f = fq[lane];
    const float h1 = sinf(f * pre);
    float pre2 = b2[lane];
#pragma unroll 1
    for (int i0 = 0; i0 < 64; i0 += 16) { float wv[16];
#pragma unroll
        for (int i = 0; i < 16; ++i) wv[i] = w2[(i0 + i) * 64 + lane];
#pragma unroll
        for (int i = 0; i < 16; ++i) pre2 += __shfl(h1, i0 + i) * wv[i]; }
    hdn2[t * 64 + lane] = sinf(f * pre2);
}

__device__ __forceinline__ void phase_p0(const Ctx& C, int l, const float* xin) {
    float* scr = (float*)(C.lds + C.wave * 8704);
    const int gw = C.bid * 8 + C.wave, NGW = C.G * 8;
    const float* w_in = C.P->in[2] + (size_t)l * 1024 * INW; const float* w_gate = C.P->in[23] + (size_t)l * 1024 * 4096; const float* w_br = C.P->in[22] + (size_t)l * 4 * 256 * 1024;
    const float* w_out = C.P->in[25] + (size_t)l * 1024 * 1024; const float* w_ff1 = C.P->in[27] + (size_t)l * 1024 * DFF; const float* w_ff3 = C.P->in[28] + (size_t)l * 1024 * DFF; const float* w_ff2 = C.P->in[29] + (size_t)l * DFF * 1024;
    constexpr int I_IN = 16 * 152, I_G = 16 * 128, I_BR = 4 * 4 * 32, I_O = 16 * 32, I_F1 = 16 * 88, I_F2 = 44 * 32;
    constexpr int NIT = I_IN + I_G + I_BR + I_O + 2 * I_F1 + I_F2;
    for (int it = gw; it < NIT; it += NGW) {
        int r = it;
        if (r < I_IN) { const int kb = r / 152, nb = r % 152; tr_tile(w_in, INW, 64 * kb, 32 * nb, C.bfp(OFF_WIN), 1024, 32 * nb, scr, C.lane); continue; } r -= I_IN;
        if (r < I_G) { const int kb = r / 128, nb = r % 128; tr_tile(w_gate, 4096, 64 * kb, 32 * nb, C.bfp(OFF_WGATE), 1024, 32 * nb, scr, C.lane); continue; } r -= I_G;
        if (r < I_BR) { const int j = r / 128, q = r % 128, kb = q / 32, nb = q % 32; tr_tile(w_br + (size_t)j * 256 * 1024, 1024, 64 * kb, 32 * nb, C.bfp(OFF_WBR) + (size_t)j * 1024 * 256, 256, 32 * nb, scr, C.lane); continue; } r -= I_BR;
        if (r < I_O) { const int kb = r / 32, nb = r % 32; tr_tile(w_out, 1024, 64 * kb, 32 * nb, C.bfp(OFF_WOUT), 1024, 32 * nb, scr, C.lane); continue; } r -= I_O;
        if (r < 2 * I_F1) { const int which = r / I_F1, q = r % I_F1, kb = q / 88, nb = q % 88, n0 = 32 * nb;
            tr_tile(which ? w_ff3 : w_ff1, DFF, 64 * kb, n0, C.bfp(OFF_WFF13), 1024, 256 * (n0 / 128) + (n0 % 128) + 128 * which, scr, C.lane); continue; } r -= 2 * I_F1;
        { const int kb = r / 32, nb = r % 32; tr_tile(w_ff2, 1024, 64 * kb, 32 * nb, C.bfp(OFF_WFF2), DFF, 32 * nb, scr, C.lane); }
    }
    for (int t = gw; t < 4096; t += NGW)
        hy_hdn_row(C.P->in[14] + (size_t)l * 33 * 64, C.P->in[15] + l * 64, C.P->in[16] + l * 64, C.P->in[17] + (size_t)l * 64 * 64, C.P->in[18] + l * 64, C.fp(OFF_HDN), t, C.lane);
    for (int row = gw; row < M_TOK; row += 2 * NGW) rms_row2_bf16(xin + (size_t)row * 1024, (size_t)NGW * 1024, C.P->in[1] + l * 1024, C.bfp(OFF_H) + (size_t)row * 1024, C.lane);
}

typedef short s16x4 __attribute__((ext_vector_type(4)));
constexpr int HPT_ = 72;
#ifndef SOFT_TR
#define SOFT_TR 0
#endif
__device__ __forceinline__ s16x4 lds_tr(const bf16_t* p) {
#if SOFT_TR
    const int fr = threadIdx.x & 15; const bf16_t* base = p - (fr >> 2) * HPT_ - 4 * (fr & 3);
    s16x4 r; r.x = (short)base[0 * HPT_ + fr]; r.y = (short)base[1 * HPT_ + fr]; r.z = (short)base[2 * HPT_ + fr]; r.w = (short)base[3 * HPT_ + fr]; return r;
#else
    return __builtin_amdgcn_ds_read_tr16_b64_v4i16((LAS s16x4*)p);
#endif
}
constexpr int HPT = 72;
template <int MODE>
__device__ __forceinline__ void hgrn_mfma(const Ctx& C, int l, int z, int b, int hd, int c, f32x4 (&Sacc)[4][4], float& dectot, unsigned char* wl, float lb) {
    const int lane = C.lane, fr = lane & 15, quad = lane >> 4;
    bf16_t* Qt = (bf16_t*)wl; bf16_t* Kb = Qt + 32 * HPT; bf16_t* Vv = Kb + 32 * HPT; float* dl = (float*)(Vv + 32 * HPT);
    const bf16_t* pa = C.bfp(OFF_PROJA); bf16_t* ya = C.bfp(OFF_YA);
    const int fcol = (z ? 512 : 256) + hd * 64 + lane, qcol = hd * 64 + lane, vcol = 768 + hd * 64 + lane;
    float gnv[4] = {0.f, 0.f, 0.f, 0.f};
    if (MODE == 2) {
#pragma unroll
        for (int vt = 0; vt < 4; ++vt) gnv[vt] = C.P->in[4][l * 256 + hd * 64 + 16 * vt + fr];
    }
#pragma unroll 1
    for (int sc = 0; sc < 4; ++sc) {
        float bacc = 0.f;
        {
            const int tl = lane >> 3, c8 = lane & 7;
            u32x4 rf[4], rv[4], rq[4];
#pragma unroll
            for (int g = 0; g < 4; ++g) { const int st = c * 128 + sc * 32 + 8 * g + tl; const int tq = z ? 4095 - st : st;
                const bf16_t* row = pa + (size_t)(b * SEQ + tq) * 1280 + hd * 64 + 8 * c8;
                rf[g] = *(const u32x4*)(row + (z ? 512 : 256)); rv[g] = *(const u32x4*)(row + 768); if (MODE != 0) rq[g] = *(const u32x4*)row; }
#pragma unroll
            for (int g = 0; g < 4; ++g) { const int t = 8 * g + tl;
                *(u32x4*)(Kb + t * HPT + 8 * c8) = rf[g]; *(u32x4*)(Vv + t * HPT + 8 * c8) = rv[g]; if (MODE != 0) *(u32x4*)(Qt + t * HPT + 8 * c8) = rq[g]; }
            wave_lds_fence();
#pragma unroll 8
            for (int t = 0; t < 32; ++t) {
                const float fl = bf2f(Kb[t * HPT + lane]);
                const float sg = sigmoidf_(fl);
                const float f = lb + (1.0f - lb) * sg, kk = (1.0f - lb) * (1.0f - sg);
                bacc += __logf(fmaxf(f, 1e-30f));
                Kb[t * HPT + lane] = f2bf(kk * __expf(fminf(-bacc, 80.f)));
                if (MODE != 0) Qt[t * HPT + lane] = f2bf(bf2f(Qt[t * HPT + lane]) * __expf(fmaxf(bacc, -80.f)));
            }
        }
        { const float eb = __expf(bacc); dl[lane] = eb; dectot *= eb; }
        wave_lds_fence();
        f32x4 Oacc[2][4];
        if (MODE != 0) {
            bf16x8 Sb[2][4];
#pragma unroll
            for (int ks = 0; ks < 2; ++ks)
#pragma unroll
                for (int vt = 0; vt < 4; ++vt) { union { bf16x8 v; unsigned u[4]; } t_;
                    t_.u[0] = cvt_pk_bf16(Sacc[2 * ks][vt][0], Sacc[2 * ks][vt][1]); t_.u[1] = cvt_pk_bf16(Sacc[2 * ks][vt][2], Sacc[2 * ks][vt][3]);
                    t_.u[2] = cvt_pk_bf16(Sacc[2 * ks + 1][vt][0], Sacc[2 * ks + 1][vt][1]); t_.u[3] = cvt_pk_bf16(Sacc[2 * ks + 1][vt][2], Sacc[2 * ks + 1][vt][3]); Sb[ks][vt] = t_.v; }
            float zz = 0.f; asm volatile("" : "+v"(zz));
#pragma unroll
            for (int tt = 0; tt < 2; ++tt)
#pragma unroll
                for (int vt = 0; vt < 4; ++vt) Oacc[tt][vt] = (f32x4){zz, zz, zz, zz};
#pragma unroll
            for (int tt = 0; tt < 2; ++tt)
#pragma unroll
                for (int ks = 0; ks < 2; ++ks) { const bf16_t* qp = Qt + (16 * tt + fr) * HPT + 32 * ks + 4 * quad;
                    union { bf16x8 v; u32x2 h[2]; } a_; a_.h[0] = *(const u32x2*)qp; a_.h[1] = *(const u32x2*)(qp + 16);
#pragma unroll
                    for (int vt = 0; vt < 4; ++vt) Oacc[tt][vt] = __builtin_amdgcn_mfma_f32_16x16x32_bf16(a_.v, Sb[ks][vt], Oacc[tt][vt], 0, 0, 0); }
            f32x4 P00 = {zz, zz, zz, zz}, P01 = {zz, zz, zz, zz}, P11 = {zz, zz, zz, zz};
#pragma unroll
            for (int ks = 0; ks < 2; ++ks) {
                const bf16x8 kA0 = *(const bf16x8*)(Kb + fr * HPT + 32 * ks + 8 * quad), kA1 = *(const bf16x8*)(Kb + (16 + fr) * HPT + 32 * ks + 8 * quad);
                const bf16x8 qB0 = *(const bf16x8*)(Qt + fr * HPT + 32 * ks + 8 * quad), qB1 = *(const bf16x8*)(Qt + (16 + fr) * HPT + 32 * ks + 8 * quad);
                P00 = __builtin_amdgcn_mfma_f32_16x16x32_bf16(kA0, qB0, P00, 0, 0, 0);
                P01 = __builtin_amdgcn_mfma_f32_16x16x32_bf16(kA0, qB1, P01, 0, 0, 0);
                P11 = __builtin_amdgcn_mfma_f32_16x16x32_bf16(kA1, qB1, P11, 0, 0, 0);
            }
#pragma unroll
            for (int r = 0; r < 4; ++r) if (4 * quad + r > fr) { P00[r] = 0.f; P11[r] = 0.f; }
            union { bf16x8 v; unsigned u[4]; } pa0, pa1;
            pa0.u[0] = cvt_pk_bf16(P00[0], P00[1]); pa0.u[1] = cvt_pk_bf16(P00[2], P00[3]); pa0.u[2] = 0u; pa0.u[3] = 0u;
            pa1.u[0] = cvt_pk_bf16(P01[0], P01[1]); pa1.u[1] = cvt_pk_bf16(P01[2], P01[3]); pa1.u[2] = cvt_pk_bf16(P11[0], P11[1]); pa1.u[3] = cvt_pk_bf16(P11[2], P11[3]);
#pragma unroll
            for (int vt = 0; vt < 4; ++vt) { const bf16_t* vp = Vv + (4 * quad + (fr >> 2)) * HPT + 16 * vt + 4 * (fr & 3);
                union { bf16x8 v; s16x4 h[2]; } vb; vb.h[0] = lds_tr(vp); vb.h[1] = lds_tr(vp + 16 * HPT);
                Oacc[0][vt] = __builtin_amdgcn_mfma_f32_16x16x32_bf16(pa0.v, vb.v, Oacc[0][vt], 0, 0, 0);
                Oacc[1][vt] = __builtin_amdgcn_mfma_f32_16x16x32_bf16(pa1.v, vb.v, Oacc[1][vt], 0, 0, 0); }
        }
        {
            bf16x8 vB[4];
#pragma unroll
            for (int vt = 0; vt < 4; ++vt) { const bf16_t* vp = Vv + (8 * quad + (fr >> 2)) * HPT + 16 * vt + 4 * (fr & 3);
                union { bf16x8 v; s16x4 h[2]; } vb; vb.h[0] = lds_tr(vp); vb.h[1] = lds_tr(vp + 4 * HPT); vB[vt] = vb.v; }
#pragma unroll
            for (int kt = 0; kt < 4; ++kt) { const bf16_t* kp = Kb + (8 * quad + (fr >> 2)) * HPT + 16 * kt + 4 * (fr & 3);
                union { bf16x8 v; s16x4 h[2]; } ka; ka.h[0] = lds_tr(kp); ka.h[1] = lds_tr(kp + 4 * HPT);
                const f32x4 d4 = *(const f32x4*)(dl + 16 * kt + 4 * quad);
#pragma unroll
                for (int vt = 0; vt < 4; ++vt) { Sacc[kt][vt] = __builtin_amdgcn_mfma_f32_16x16x32_bf16(ka.v, vB[vt], Sacc[kt][vt], 0, 0, 0); Sacc[kt][vt] *= d4; } }
        }
        if (MODE == 1) {
#pragma unroll
            for (int tt = 0; tt < 2; ++tt)
#pragma unroll
                for (int r = 0; r < 4; ++r) { const int st = c * 128 + sc * 32 + 16 * tt + 4 * quad + r; const int tq = z ? 4095 - st : st;
                    bf16_t* yp = ya + (size_t)(b * SEQ + tq) * 256 + hd * 64 + fr;
#pragma unroll
                    for (int vt = 0; vt < 4; ++vt) yp[16 * vt] = f2bf(Oacc[tt][vt][r]); }
        }
        if (MODE == 2) {
#pragma unroll
            for (int tt = 0; tt < 2; ++tt) {
                bf16_t tmpv[4][4], gtv[4][4];
#pragma unroll
                for (int r = 0; r < 4; ++r) { const int st = c * 128 + sc * 32 + 16 * tt + 4 * quad + r; const int tq = z ? 4095 - st : st;
                    const size_t tok = (size_t)(b * SEQ + tq); const bf16_t* yp = ya + tok * 256 + hd * 64 + fr; const bf16_t* gp = pa + tok * 1280 + 1024 + hd * 64 + fr;
#pragma unroll
                    for (int vt = 0; vt < 4; ++vt) { tmpv[r][vt] = yp[16 * vt]; gtv[r][vt] = gp[16 * vt]; } }
#pragma unroll
                for (int r = 0; r < 4; ++r) { const int st = c * 128 + sc * 32 + 16 * tt + 4 * quad + r; const int tq = z ? 4095 - st : st;
                    bf16_t* yp = ya + (size_t)(b * SEQ + tq) * 256 + hd * 64 + fr;
                    float o[4]; float ss = 0.f;
#pragma unroll
                    for (int vt = 0; vt < 4; ++vt) { o[vt] = Oacc[tt][vt][r] + bf2f(tmpv[r][vt]); ss += o[vt] * o[vt]; }
                    ss += __shfl_xor(ss, 1); ss += __shfl_xor(ss, 2); ss += __shfl_xor(ss, 4); ss += __shfl_xor(ss, 8);
                    const float rs = rsqrtf(ss * (1.f / 64.f) + 1e-6f);
#pragma unroll
                    for (int vt = 0; vt < 4; ++vt) yp[16 * vt] = f2bf(o[vt] * rs * gnv[vt] * siluf_(bf2f(gtv[r][vt]))); }
                asm volatile("" ::: "memory");
            }
        }
        wave_lds_fence();
    }
}
__device__ __forceinline__ float hgrn_lb(const Ctx& C, int l, int ch) {
    if (l == 0) return 0.f;
    const float a0 = C.P->in[3][ch], a1 = C.P->in[3][256 + ch];
    return 1.0f / (1.0f + __expf(a0 - a1));
}
__device__ __forceinline__ void hgrn_state_load(const float* sb, f32x4 (&Sacc)[4][4], int fr, int quad) {
#pragma unroll
    for (int kt = 0; kt < 4; ++kt)
#pragma unroll
        for (int vt = 0; vt < 4; ++vt)
#pragma unroll
            for (int r = 0; r < 4; ++r) Sacc[kt][vt][r] = sb[(16 * kt + 4 * quad + r) * 64 + 16 * vt + fr];
}
__device__ __forceinline__ void hgrn_pass1_item(const Ctx& C, int l, int item) {
    const int c = item & 31, hd = (item >> 5) & 3, b = (item >> 7) & 7, z = item >> 10;
    unsigned char* wl = C.lds + C.wave * 14336;
    f32x4 Sacc[4][4];
#pragma unroll
    for (int kt = 0; kt < 4; ++kt)
#pragma unroll
        for (int vt = 0; vt < 4; ++vt) Sacc[kt][vt] = (f32x4){0.f, 0.f, 0.f, 0.f};
    float dectot = 1.f;
    hgrn_mfma<0>(C, l, z, b, hd, c, Sacc, dectot, wl, hgrn_lb(C, l, hd * 64 + C.lane));
    float* sb = C.fp(OFF_S) + (size_t)item * 4096;
    const int fr = C.lane & 15, quad = C.lane >> 4;
#pragma unroll
    for (int kt = 0; kt < 4; ++kt)
#pragma unroll
        for (int vt = 0; vt < 4; ++vt)
#pragma unroll
            for (int r = 0; r < 4; ++r) sb[(16 * kt + 4 * quad + r) * 64 + 16 * vt + fr] = Sacc[kt][vt][r];
    C.fp(OFF_DEC)[item * 64 + C.lane] = dectot;
}
template <int DIR>
__device__ __forceinline__ void hgrn_pass3_item(const Ctx& C, int l, int item) {
    const int c = item & 31, hd = (item >> 5) & 3, b = item >> 7;
    unsigned char* wl = C.lds + C.wave * 14336;
    const float lb = hgrn_lb(C, l, hd * 64 + C.lane);
    const int fr = C.lane & 15, quad = C.lane >> 4;
    f32x4 Sacc[4][4]; float dectot = 1.f;
    if (DIR == 1) {
        hgrn_state_load(C.fp(OFF_S) + (size_t)((((1 * 8 + b) * 4 + hd) * 32) + (31 - c)) * 4096, Sacc, fr, quad);
        hgrn_mfma<1>(C, l, 1, b, hd, 31 - c, Sacc, dectot, wl, lb);
    } else {
        hgrn_state_load(C.fp(OFF_S) + (size_t)((((0 * 8 + b) * 4 + hd) * 32) + c) * 4096, Sacc, fr, quad);
        hgrn_mfma<2>(C, l, 0, b, hd, c, Sacc, dectot, wl, lb);
    }
}
template <int MODE>
__device__ __forceinline__ void hgrn_run(const Ctx& C, int l, int z, int b, int hd, int c, float (&S)[64], float& decp, float* wl, float lb) {
    const int lane = C.lane;
    float* F = wl; float* Q = wl + 1024; float* V = wl + 2048;
    const bf16_t* pa = C.bfp(OFF_PROJA);
    bf16_t* ya = C.bfp(OFF_YA);
    const int fcol = (z ? 512 : 256) + hd * 64 + lane, qcol = hd * 64 + lane, vcol = 768 + hd * 64 + lane, gcol = 1024 + hd * 64 + lane;
    const float gn = (MODE == 2) ? C.P->in[4][l * 256 + hd * 64 + lane] : 0.f;
    for (int sb = 0; sb < 8; ++sb) {
#pragma unroll 4
        for (int ss = 0; ss < 16; ++ss) {
            const int s = sb * 16 + ss; const int tq = z ? (4095 - (c * 128 + s)) : (c * 128 + s);
            const bf16_t* row = pa + (size_t)(b * SEQ + tq) * 1280;
            const float fl = bf2f(row[fcol]);
            const float f = lb + (1.0f - lb) * sigmoidf_(fl);
            F[ss * 64 + lane] = f; Q[ss * 64 + lane] = bf2f(row[qcol]); V[ss * 64 + lane] = bf2f(row[vcol]);
            decp *= f;
        }
        wave_lds_fence();
        for (int ss = 0; ss < 16; ++ss) {
            const float v = V[ss * 64 + lane]; float o = 0.f;
            const f32x4* F4 = (const f32x4*)(F + ss * 64); const f32x4* Q4 = (const f32x4*)(Q + ss * 64);
#pragma unroll
            for (int i4 = 0; i4 < 16; ++i4) {
                const f32x4 f4 = F4[i4];
                S[4 * i4 + 0] = fmaf(f4.x, S[4 * i4 + 0] - v, v); S[4 * i4 + 1] = fmaf(f4.y, S[4 * i4 + 1] - v, v);
                S[4 * i4 + 2] = fmaf(f4.z, S[4 * i4 + 2] - v, v); S[4 * i4 + 3] = fmaf(f4.w, S[4 * i4 + 3] - v, v);
                if (MODE != 0) { const f32x4 q4 = Q4[i4];
                    o = fmaf(q4.x, S[4 * i4 + 0], o); o = fmaf(q4.y, S[4 * i4 + 1], o); o = fmaf(q4.z, S[4 * i4 + 2], o); o = fmaf(q4.w, S[4 * i4 + 3], o); }
            }
            if (MODE != 0) {
                const int s = sb * 16 + ss; const int tq = z ? (4095 - (c * 128 + s)) : (c * 128 + s);
                const size_t tok = (size_t)(b * SEQ + tq);
                if (MODE == 1) ya[tok * 256 + hd * 64 + lane] = f2bf(o);
                else {
                    o += bf2f(ya[tok * 256 + hd * 64 + lane]);
                    const float ms = wave_sum(o * o) * (1.f / 64.f);
                    const float gate = bf2f(pa[tok * 1280 + gcol]);
                    ya[tok * 256 + hd * 64 + lane] = f2bf(o * rsqrtf(ms + 1e-6f) * gn * siluf_(gate));
                }
            }
        }
        wave_lds_fence();
    }
}
__device__ __forceinline__ void hgrn_pass1_old(const Ctx& C, int l, int item) {
    const int c = item & 31, hd = (item >> 5) & 3, b = (item >> 7) & 7, z = item >> 10;
    float* wl = (float*)(C.lds + C.wave * 12288);
    float S[64];
#pragma unroll
    for (int i = 0; i < 64; ++i) S[i] = 0.f;
    float decp = 1.f;
    hgrn_run<0>(C, l, z, b, hd, c, S, decp, wl, hgrn_lb(C, l, hd * 64 + C.lane));
    float* sb = C.fp(OFF_S) + (size_t)item * 4096;
#pragma unroll
    for (int i = 0; i < 64; ++i) sb[i * 64 + C.lane] = S[i];
    C.fp(OFF_DEC)[item * 64 + C.lane] = decp;
}
__device__ __forceinline__ void hgrn_pass3_old(const Ctx& C, int l, int item) {
    const int c = item & 31, hd = (item >> 5) & 3, b = item >> 7;
    float* wl = (float*)(C.lds + C.wave * 12288);
    const float lb = hgrn_lb(C, l, hd * 64 + C.lane);
    float S[64]; float decp = 1.f;
    {
        const int it1 = (((1 * 8 + b) * 4 + hd) * 32) + (31 - c);
        const float* sb = C.fp(OFF_S) + (size_t)it1 * 4096;
#pragma unroll
        for (int i = 0; i < 64; ++i) S[i] = sb[i * 64 + C.lane];
        hgrn_run<1>(C, l, 1, b, hd, 31 - c, S, decp, wl, lb);
    }
    __threadfence();
    {
        const int it0 = (((0 * 8 + b) * 4 + hd) * 32) + c;
        const float* sb = C.fp(OFF_S) + (size_t)it0 * 4096;
#pragma unroll
        for (int i = 0; i < 64; ++i) S[i] = sb[i * 64 + C.lane];
        hgrn_run<2>(C, l, 0, b, hd, c, S, decp, wl, lb);
    }
}
__device__ __forceinline__ void hgrn_scan(const Ctx& C) {
    float* Sb = C.fp(OFF_S); const float* dec = C.fp(OFF_DEC);
    for (int idx = C.bid * NTHR + C.tid; idx < 64 * 4096; idx += C.G * NTHR) {
        const int seq = idx >> 12, e = idx & 4095, i = e >> 6;
        float tv[32], dv[32];
#pragma unroll
        for (int c = 0; c < 32; ++c) { const size_t it = (size_t)seq * 32 + c; tv[c] = Sb[it * 4096 + e]; dv[c] = dec[it * 64 + i]; }
        float run = 0.f;
#pragma unroll
        for (int c = 0; c < 32; ++c) { const size_t it = (size_t)seq * 32 + c; Sb[it * 4096 + e] = run; run = dv[c] * run + tv[c]; }
    }
}

constexpr int XCP = 264;
template <bool FINAL>
__device__ __forceinline__ void lru_item(const Ctx& C, int l, int item) {
    const int b = item >> 6, c = item & 63, tid = C.tid, lane = C.lane, w = C.wave, fr = lane & 15, quad = lane >> 4;
    bf16_t* xc = (bf16_t*)C.lds;
    float* Al = (float*)(C.lds + 33792 + w * 6528); bf16_t* Ul = (bf16_t*)(Al + 16 * 68);
    bf16_t* H0 = (bf16_t*)(C.lds + 86016); bf16_t* H1 = H0 + 64 * 256;
    const bf16_t* pb = C.bfp(OFF_PROJB);
    const int n = w & 3, z = w >> 2;
    bf16x8 Bw[2][4][2];
#pragma unroll
        for (int ty = 0; ty < 2; ++ty)
#pragma unroll
            for (int ks = 0; ks < 2; ++ks) {
                const float* wp = (ty ? C.P->in[9] : C.P->in[7]) + ((size_t)((l * 2 + z) * 4 + n) * 64 + 32 * ks + 8 * quad) * 64 + fr;
                asm volatile("" : "+v"(wp));
                float f[4][8];
#pragma unroll
                for (int dt = 0; dt < 4; ++dt)
#pragma unroll
                    for (int e = 0; e < 8; ++e) f[dt][e] = wp[e * 64 + 16 * dt];
#pragma unroll
                for (int dt = 0; dt < 4; ++dt) {
                    union { bf16x8 v; unsigned u[4]; } t_; t_.u[0] = cvt_pk_bf16(f[dt][0], f[dt][1]); t_.u[1] = cvt_pk_bf16(f[dt][2], f[dt][3]); t_.u[2] = cvt_pk_bf16(f[dt][4], f[dt][5]); t_.u[3] = cvt_pk_bf16(f[dt][6], f[dt][7]); Bw[ty][dt][ks] = t_.v; }
                asm volatile("" ::: "memory");
            }
    {
        int ch = tid & 255; asm volatile("" : "+v"(ch)); const int hf = tid >> 8;
        const float w0 = C.P->in[5][(l * 4 + 0) * 256 + ch], w1 = C.P->in[5][(l * 4 + 1) * 256 + ch], w2 = C.P->in[5][(l * 4 + 2) * 256 + ch], w3 = C.P->in[5][(l * 4 + 3) * 256 + ch], cb = C.P->in[6][l * 256 + ch];
        const int tl0 = hf * 32, t0 = c * 64 + tl0;
        const bf16_t* colp = pb + (size_t)(b * SEQ) * 512 + ch;
        float xm2 = (t0 - 2 >= 0) ? bf2f(colp[(size_t)(t0 - 2) * 512]) : 0.f, xm1 = (t0 - 1 >= 0) ? bf2f(colp[(size_t)(t0 - 1) * 512]) : 0.f, x0 = bf2f(colp[(size_t)t0 * 512]);
#pragma unroll 1
        for (int k8 = 0; k8 < 4; ++k8) { float xn[8];
#pragma unroll
            for (int k = 0; k < 8; ++k) { const int t = t0 + k8 * 8 + k + 1; xn[k] = (t < SEQ) ? bf2f(colp[(size_t)t * 512]) : 0.f; }
#pragma unroll
            for (int k = 0; k < 8; ++k) { xc[(tl0 + k8 * 8 + k) * XCP + ch] = f2bf(cb + w0 * xm2 + w1 * xm1 + w2 * x0 + w3 * xn[k]); xm2 = xm1; xm1 = x0; x0 = xn[k]; } }
    }
    __syncthreads();
    {
        float bav[4], bxv[4], spv[4];
#pragma unroll
        for (int dt = 0; dt < 4; ++dt) { const int chd = n * 64 + 16 * dt + fr; bav[dt] = C.P->in[8][(l * 2 + z) * 256 + chd]; bxv[dt] = C.P->in[10][(l * 2 + z) * 256 + chd];
            const float lam = C.P->in[11][(l * 2 + z) * 256 + chd]; spv[dt] = (-lam > 15.f) ? -lam : log1pf(__expf(-lam)); }
        const size_t cidx = (size_t)((z * 8 + b) * 64 + c) * 256 + n * 64 + lane;
        float h = FINAL ? C.fp(OFF_CARH)[cidx] : 0.f, Ap = 1.f;
        bf16_t* Hz = z ? H1 : H0;
#pragma unroll 1
        for (int s4 = 0; s4 < 4; ++s4) { const int tt = z ? 3 - s4 : s4;
            const bf16_t* xrow = xc + (16 * tt + fr) * XCP + n * 64 + 8 * quad;
            const bf16x8 xa0 = *(const bf16x8*)xrow, xa1 = *(const bf16x8*)(xrow + 32);
#pragma unroll
            for (int dt = 0; dt < 4; ++dt) {
                f32x4 Da = {0.f, 0.f, 0.f, 0.f}, Dx = {0.f, 0.f, 0.f, 0.f};
                Da = __builtin_amdgcn_mfma_f32_16x16x32_bf16(xa0, Bw[0][dt][0], Da, 0, 0, 0); Da = __builtin_amdgcn_mfma_f32_16x16x32_bf16(xa1, Bw[0][dt][1], Da, 0, 0, 0);
                Dx = __builtin_amdgcn_mfma_f32_16x16x32_bf16(xa0, Bw[1][dt][0], Dx, 0, 0, 0); Dx = __builtin_amdgcn_mfma_f32_16x16x32_bf16(xa1, Bw[1][dt][1], Dx, 0, 0, 0);
#pragma unroll
                for (int r = 0; r < 4; ++r) { const int tloc = 4 * quad + r, d = 16 * dt + fr;
                    const float rg = sigmoidf_(Da[r] + bav[dt]), ig = sigmoidf_(Dx[r] + bxv[dt]), la = -8.0f * rg * spv[dt], a = __expf(la);
                    const float x = bf2f(xc[(16 * tt + tloc) * XCP + n * 64 + d]);
                    Al[tloc * 68 + d] = a; Ul[tloc * 68 + d] = f2bf(sqrtf(fmaxf(1.0f - a * a, 0.f)) * ig * x); }
            }
            wave_lds_fence();
#pragma unroll
            for (int j = 0; j < 16; ++j) { const int tloc = z ? 15 - j : j;
                const float a = Al[tloc * 68 + lane], u = bf2f(Ul[tloc * 68 + lane]);
                h = fmaf(a, h, u); Ap *= a;
                if (FINAL) Hz[(16 * tt + tloc) * 256 + n * 64 + lane] = f2bf(h); }
            wave_lds_fence();
        }
        if (!FINAL) { C.fp(OFF_CARA)[cidx] = Ap; C.fp(OFF_CARH)[cidx] = h; }
    }
    if (FINAL) {
        __syncthreads();
        int ch = tid & 255; asm volatile("" : "+v"(ch)); const int zz = tid >> 8;
        const bf16_t* gp = pb + (size_t)(b * SEQ + c * 64) * 512 + 256 + ch; bf16_t* yb = C.bfp(OFF_YB) + (size_t)(b * SEQ + c * 64) * 256 + ch;
#pragma unroll 1
        for (int k8 = 0; k8 < 4; ++k8) { bf16_t gv_[8];
#pragma unroll
            for (int k = 0; k < 8; ++k) gv_[k] = gp[(size_t)(zz * 32 + k8 * 8 + k) * 512];
#pragma unroll
            for (int k = 0; k < 8; ++k) { const int tl = zz * 32 + k8 * 8 + k; const float hs = bf2f(H0[tl * 256 + ch]) + bf2f(H1[tl * 256 + ch]);
                yb[(size_t)tl * 256] = f2bf(hs * geluf_(bf2f(gv_[k]))); } }
    }
    __syncthreads();
}
__device__ __forceinline__ void lru_scan(const Ctx& C) {
    float* ca = C.fp(OFF_CARA); float* chh = C.fp(OFF_CARH);
    if (C.tid < 16) for (int idx = C.bid * 16 + C.tid; idx < 4096; idx += C.G * 16) {
        const int ch = idx & 255, zb = idx >> 8, z = zb >> 3;
        float run = 0.f;
#pragma unroll 1
        for (int hh = 0; hh < 2; ++hh) {
            float av[32], hv[32];
#pragma unroll
            for (int k = 0; k < 32; ++k) { const int kk = hh * 32 + k, c = z ? 63 - kk : kk; const size_t i = (size_t)(zb * 64 + c) * 256 + ch; av[k] = ca[i]; hv[k] = chh[i]; }
#pragma unroll
            for (int k = 0; k < 32; ++k) { const int kk = hh * 32 + k, c = z ? 63 - kk : kk; const size_t i = (size_t)(zb * 64 + c) * 256 + ch; chh[i] = run; run = av[k] * run + hv[k]; }
        }
    }
}

__device__ __forceinline__ void hy_tr_item(const Ctx& C, int l, int item) {
    const int cb = item / 512, tb = item % 512, lane = C.lane, tok0 = tb * 64;
    bf16_t* tile = (bf16_t*)(C.lds + C.wave * 8960);
    const bf16_t* pc = C.bfp(OFF_PROJC);
    const bool first = (tok0 % SEQ) == 0, lastb = ((tok0 + 64) % SEQ) == 0;
#pragma unroll 1
    for (int r0 = 0; r0 < 66; r0 += 22) { bf16_t tv_[22];
#pragma unroll
        for (int q = 0; q < 22; ++q) { const int rr = r0 + q; bf16_t v = 0;
            if (!((rr == 0 && first) || (rr == 65 && lastb))) v = pc[(size_t)(tok0 - 1 + rr) * 768 + cb * 64 + lane];
            tv_[q] = v; }
#pragma unroll
        for (int q = 0; q < 22; ++q) tile[(r0 + q) * 66 + lane] = tv_[q]; }
    wave_lds_fence();
    bf16_t* uct = C.bfp(OFF_UCT);
    const float w0v = C.P->in[12][(l * 3 + 0) * 768 + cb * 64 + lane], w1v = C.P->in[12][(l * 3 + 1) * 768 + cb * 64 + lane], w2v = C.P->in[12][(l * 3 + 2) * 768 + cb * 64 + lane], bbv = C.P->in[13][l * 768 + cb * 64 + lane];
#pragma unroll 8
    for (int ch = 0; ch < 64; ++ch) { const int cch = cb * 64 + ch;
        const float w0 = __shfl(w0v, ch), w1 = __shfl(w1v, ch), w2 = __shfl(w2v, ch), bb = __shfl(bbv, ch);
        const float v = bb + w0 * bf2f(tile[lane * 66 + ch]) + w1 * bf2f(tile[(lane + 1) * 66 + ch]) + w2 * bf2f(tile[(lane + 2) * 66 + ch]);
        uct[(size_t)cch * M_TOK + tok0 + lane] = f2bf(v); }
    wave_lds_fence();
}
__device__ __forceinline__ void hy_out_tr_item(const Ctx& C, int item) {
    const int cb = item / 512, tb = item % 512, lane = C.lane, tok0 = tb * 64;
    bf16_t* tile = (bf16_t*)(C.lds + C.wave * 8704);
    const bf16_t* yct = C.bfp(OFF_YCT); bf16_t* yc = C.bfp(OFF_YC);
#pragma unroll 1
    for (int c0 = 0; c0 < 64; c0 += 16) { bf16_t tv_[16];
#pragma unroll
        for (int q = 0; q < 16; ++q) tv_[q] = yct[(size_t)(cb * 64 + c0 + q) * M_TOK + tok0 + lane];
#pragma unroll
        for (int q = 0; q < 16; ++q) tile[(c0 + q) * 66 + lane] = tv_[q]; }
    wave_lds_fence();
    for (int tl = 0; tl < 64; ++tl) yc[(size_t)(tok0 + tl) * 256 + cb * 64 + lane] = tile[lane * 66 + tl];
    wave_lds_fence();
}
constexpr int GLEN = 8704, GOFF = 4352, UP = 5128, URO = 4599;
__device__ __forceinline__ void hy_conv(const bf16_t* Gf0, const bf16_t* Gf1, const bf16_t* Ur, f32x16 (&acc)[4], int w, int lane) {
    const int i = lane & 31, h = lane >> 5, bb = (lane >> 2) & 7, jj = lane & 3;
    const int T0 = 96 + 512 * w;
#pragma unroll
    for (int mm = 0; mm < 4; ++mm)
#pragma unroll
        for (int r = 0; r < 16; ++r) acc[mm][r] = 0.f;
    const int P0 = GOFF + (T0 - 4192) + i - 8 * h - 7;
    const bf16_t* gp = ((P0 & 1) ? Gf1 : Gf0) + (P0 & ~1);
    const bf16_t* up = Ur + bb * UP + (URO - 7 - 8 * h + 32 * jj - 4192);
    int nit = 287; asm volatile("" : "+s"(nit));
    union AF { bf16x8 v; unsigned u[4]; };
    AF ac; bf16x8 bc[4];
    { const unsigned* g4 = (const unsigned*)gp; ac.u[0] = g4[0]; ac.u[1] = g4[1]; ac.u[2] = g4[2]; ac.u[3] = g4[3];
#pragma unroll
      for (int mm = 0; mm < 4; ++mm) bc[mm] = *(const bf16x8*)(up - 128 * mm); }
#pragma unroll 2
    for (int it = 0; it < nit; ++it) {
        const int itn = (it + 1 < nit) ? it + 1 : it;
        AF an; bf16x8 bn[4];
        { const unsigned* g4 = (const unsigned*)(gp + 16 * itn); an.u[0] = g4[0]; an.u[1] = g4[1]; an.u[2] = g4[2]; an.u[3] = g4[3];
#pragma unroll
          for (int mm = 0; mm < 4; ++mm) bn[mm] = *(const bf16x8*)(up + 16 * itn - 128 * mm); }
#pragma unroll
        for (int mm = 0; mm < 4; ++mm) acc[mm] = __builtin_amdgcn_mfma_f32_32x32x16_bf16(ac.v, bc[mm], acc[mm], 0, 0, 0);
        ac = an;
#pragma unroll
        for (int mm = 0; mm < 4; ++mm) bc[mm] = bn[mm];
    }
}
__device__ __forceinline__ unsigned rev16(unsigned x) { return (x >> 16) | (x << 16); }
__device__ __forceinline__ void hy_conv_item(const Ctx& C, int l, int c) {
    const int tid = C.tid, lane = C.lane, w = C.wave;
    bf16_t* G10 = (bf16_t*)C.lds; bf16_t* G11 = G10 + GLEN; bf16_t* G20 = G11 + GLEN; bf16_t* G21 = G20 + GLEN; bf16_t* U = G21 + GLEN;
    float* red = (float*)(C.lds + (size_t)(4 * GLEN + 8 * UP) * 2); float* w3s = red + 64;
    for (int i = tid; i < 2 * GLEN; i += NTHR) ((unsigned*)G10)[i] = 0u;
    if (tid < 256) { const int q = tid >> 6, j = tid & 63; const int col = (q >> 1) * 512 + (q & 1) * 256 + c; w3s[q * 64 + j] = C.P->in[19][((size_t)l * 64 + j) * 1024 + col]; }
    __syncthreads();
    float ss[4] = {0.f, 0.f, 0.f, 0.f};
    const float adelta = 3.0701134573253945f + (float)c * ((15.350567286626972f - 3.0701134573253945f) / 255.f);
    const float* hdn = C.fp(OFF_HDN);
    float* hft = (float*)U;
#pragma unroll 1
    for (int k = 0; k < 8; ++k) { const int t = tid + NTHR * k; const f32x4* hr = (const f32x4*)(hdn + (size_t)t * 64);
        float a0 = 0.f, a1 = 0.f, a2 = 0.f, a3 = 0.f;
#pragma unroll 1
        for (int j8 = 0; j8 < 16; j8 += 8) {
        f32x4 hrow[8];
#pragma unroll
        for (int j4 = 0; j4 < 8; ++j4) hrow[j4] = hr[j8 + j4];
#pragma unroll
        for (int jj4 = 0; jj4 < 8; ++jj4) { const f32x4 hv = hrow[jj4]; const int j4 = j8 + jj4;
            const f32x4 q0 = *(const f32x4*)(w3s + 4 * j4), q1 = *(const f32x4*)(w3s + 64 + 4 * j4), q2 = *(const f32x4*)(w3s + 128 + 4 * j4), q3 = *(const f32x4*)(w3s + 192 + 4 * j4);
            a0 += hv.x * q0.x + hv.y * q0.y + hv.z * q0.z + hv.w * q0.w; a1 += hv.x * q1.x + hv.y * q1.y + hv.z * q1.z + hv.w * q1.w;
            a2 += hv.x * q2.x + hv.y * q2.y + hv.z * q2.z + hv.w * q2.w; a3 += hv.x * q3.x + hv.y * q3.y + hv.z * q3.z + hv.w * q3.w; } }
        const float dec = __expf(-((float)t / 4095.f) * adelta);
        a0 *= dec; a1 *= dec; a2 *= dec; a3 *= dec;
        hft[t] = a0; hft[4096 + t] = a1; hft[8192 + t] = a2; hft[12288 + t] = a3;
        ss[0] += a0 * a0; ss[1] += a1 * a1; ss[2] += a2 * a2; ss[3] += a3 * a3; }
#pragma unroll
    for (int q = 0; q < 4; ++q) { const float s_ = wave_sum(ss[q]); if (lane == 0) red[w * 4 + q] = s_; }
    __syncthreads();
    float sc[4];
#pragma unroll
    for (int q = 0; q < 4; ++q) { float s_ = 0.f; for (int ww = 0; ww < 8; ++ww) s_ += red[ww * 4 + q]; sc[q] = rsqrtf(s_ + 1e-6f); }
#pragma unroll 1
    for (int k = 0; k < 8; ++k) { const int t = tid + NTHR * k;
        const float h0 = hft[t] * sc[0], h1 = hft[4096 + t] * sc[1], h2 = hft[8192 + t] * sc[2], h3 = hft[12288 + t] * sc[3];
        if (t == 0) { const bf16_t v1 = f2bf(h0 + h1 + C.P->in[20][(l * 2 + 0) * 256 + c]), v2 = f2bf(h2 + h3 + C.P->in[20][(l * 2 + 1) * 256 + c]);
            G10[GOFF] = v1; G11[GOFF - 1] = v1; G20[GOFF] = v2; G21[GOFF - 1] = v2; }
        else { const bf16_t f1 = f2bf(h0), b1 = f2bf(h1), f2 = f2bf(h2), b2 = f2bf(h3);
            G10[GOFF + t] = f1; G11[GOFF + t - 1] = f1; G10[GOFF - t] = b1; G11[GOFF - t - 1] = b1;
            G20[GOFF + t] = f2; G21[GOFF + t - 1] = f2; G20[GOFF - t] = b2; G21[GOFF - t - 1] = b2; } }
    __syncthreads();
    for (int i = tid; i < 8 * UP / 2; i += NTHR) ((unsigned*)U)[i] = 0u;
    __syncthreads();
    bf16_t* uct = C.bfp(OFF_UCT);
    const bf16_t* vsrc = uct + (size_t)c * M_TOK; const bf16_t* x1src = uct + (size_t)(256 + c) * M_TOK; const bf16_t* x2src = uct + (size_t)(512 + c) * M_TOK;
    {
        u32x4 vin[8];
#pragma unroll
        for (int k = 0; k < 8; ++k) { const int id = tid + NTHR * k, bb_ = id >> 9, off = (id & 511) * 8; vin[k] = *(const u32x4*)(vsrc + (size_t)bb_ * SEQ + off); }
#pragma unroll
        for (int k = 0; k < 8; ++k) { const int id = tid + NTHR * k, bb_ = id >> 9, off = (id & 511) * 8;
            u32x4 o; o.x = rev16(vin[k].w); o.y = rev16(vin[k].z); o.z = rev16(vin[k].y); o.w = rev16(vin[k].x);
            *(u32x4*)(U + bb_ * UP + (URO - 7 - off)) = o; }
    }
    __syncthreads();
    f32x16 acc[4];
    const int h = lane >> 5, bb = (lane >> 2) & 7, jj = lane & 3;
    hy_conv(G10, G11, U, acc, w, lane);
    __syncthreads();
    u32x2 xall[4][4];
#pragma unroll
    for (int mm = 0; mm < 4; ++mm)
#pragma unroll
        for (int k4 = 0; k4 < 4; ++k4) { const int t = 96 + 512 * w + 128 * mm - 32 * jj + 8 * k4 + 4 * h; xall[mm][k4] = *(const u32x2*)(x1src + (size_t)bb * SEQ + t); }
#pragma unroll
    for (int mm = 0; mm < 4; ++mm)
#pragma unroll
        for (int k4 = 0; k4 < 4; ++k4) { const int t = 96 + 512 * w + 128 * mm - 32 * jj + 8 * k4 + 4 * h;
            const u32x2 xv = xall[mm][k4];
            u32x2 o; o.x = cvt_pk_bf16(acc[mm][4 * k4 + 3] * bfhi(xv.y), acc[mm][4 * k4 + 2] * bflo(xv.y)); o.y = cvt_pk_bf16(acc[mm][4 * k4 + 1] * bfhi(xv.x), acc[mm][4 * k4] * bflo(xv.x));
            *(u32x2*)(U + bb * UP + (URO - 3 - t)) = o; }
    __syncthreads();
    hy_conv(G20, G21, U, acc, w, lane);
    bf16_t* ydst = C.bfp(OFF_YCT) + (size_t)c * M_TOK;
#pragma unroll
    for (int mm = 0; mm < 4; ++mm)
#pragma unroll
        for (int k4 = 0; k4 < 4; ++k4) { const int t = 96 + 512 * w + 128 * mm - 32 * jj + 8 * k4 + 4 * h; xall[mm][k4] = *(const u32x2*)(x2src + (size_t)bb * SEQ + t); }
#pragma unroll
    for (int mm = 0; mm < 4; ++mm)
#pragma unroll
        for (int k4 = 0; k4 < 4; ++k4) { const int t = 96 + 512 * w + 128 * mm - 32 * jj + 8 * k4 + 4 * h;
            const u32x2 xv = xall[mm][k4];
            u32x2 o; o.x = cvt_pk_bf16(acc[mm][4 * k4] * bflo(xv.x), acc[mm][4 * k4 + 1] * bfhi(xv.x)); o.y = cvt_pk_bf16(acc[mm][4 * k4 + 2] * bflo(xv.y), acc[mm][4 * k4 + 3] * bfhi(xv.y));
            *(u32x2*)(ydst + (size_t)bb * SEQ + t) = o; }
    __syncthreads();
}

__device__ __forceinline__ void attn_fetch(const Ctx& C, int it, u32x4 (&kv)[4], u32x4 (&vv)[4], u32x4 (&qv)[2]) {
    const int tid = C.tid;
    const int b = it / 384, rem = it % 384, hq = rem >> 5, kk = rem & 31, g = hq >> 2, dil = 1 << (2 * g), n = SEQ / dil, nblk = 32 / dil, r = kk / nblk, jb = kk % nblk;
    const bf16_t* pd = C.bfp(OFF_PROJD);
#pragma unroll
    for (int k = 0; k < 4; ++k) { const int id = tid + NTHR * k, cidx = id >> 3, ch = id & 7, ik = 128 * jb - 64 + cidx;
        kv[k] = (u32x4){0u, 0u, 0u, 0u}; vv[k] = (u32x4){0u, 0u, 0u, 0u};
        if (ik >= 0 && ik < n) { const bf16_t* row = pd + (size_t)(b * SEQ + r + dil * ik) * 2304; kv[k] = *(const u32x4*)(row + 768 + hq * 64 + ch * 8); vv[k] = *(const u32x4*)(row + 1536 + hq * 64 + ch * 8); } }
#pragma unroll
    for (int k = 0; k < 2; ++k) { const int id = tid + NTHR * k, a = id >> 3, ch = id & 7;
        qv[k] = *(const u32x4*)(pd + (size_t)(b * SEQ + r + dil * (128 * jb + a)) * 2304 + hq * 64 + ch * 8); }
}
__device__ __forceinline__ void attn_item(const Ctx& C, int it, int itn, u32x4 (&kv)[4], u32x4 (&vv)[4], u32x4 (&qv)[2]) {
    const int tid = C.tid, lane = C.lane, w = C.wave;
    const int b = it / 384, rem = it % 384, hq = rem >> 5, kk = rem & 31, g = hq >> 2, dil = 1 << (2 * g), n = SEQ / dil, nblk = 32 / dil, r = kk / nblk, jb = kk % nblk;
    bf16_t* Ks = (bf16_t*)C.lds; bf16_t* Qs = Ks + 256 * 72; bf16_t* Vs = Qs + 128 * 72; float* bt = (float*)(Vs + 256 * 72);
    bf16_t* pd = C.bfp(OFF_PROJD);
    if (tid < 129) { const int rel = (tid - 64) * dil, na = rel < 0 ? -rel : rel;
        int bk = na < 8 ? na : 8 + (na >= 15) + (na >= 27) + (na >= 50) + (na >= 91) + (na >= 166) + (na >= 305) + (na >= 559);
        if (rel > 0) bk += 16;
        bt[tid] = C.P->in[21][bk * 12 + hq]; }
    {
#pragma unroll
        for (int k = 0; k < 4; ++k) { const int id = tid + NTHR * k, cidx = id >> 3, ch = id & 7;
            *(u32x4*)(Ks + cidx * 72 + ch * 8) = kv[k];
            *(u32x4*)(Vs + cidx * 72 + ch * 8) = vv[k]; }
#pragma unroll
        for (int k = 0; k < 2; ++k) { const int id = tid + NTHR * k, a = id >> 3, ch = id & 7; *(u32x4*)(Qs + a * 72 + ch * 8) = qv[k]; }
    }
    if (itn < 3072) attn_fetch(C, itn, kv, vv, qv);
    __syncthreads();
    const int fr = lane & 15, quad = lane >> 4;
    bf16x8 qf[2];
    qf[0] = *(const bf16x8*)(Qs + (16 * w + fr) * 72 + 8 * quad); qf[1] = *(const bf16x8*)(Qs + (16 * w + fr) * 72 + 32 + 8 * quad);
    f32x4 sc[9];
#pragma unroll
    for (int kt = 0; kt < 9; ++kt) { const bf16_t* kr = Ks + (16 * (w + kt) + fr) * 72 + 8 * quad;
        const bf16x8 k0 = *(const bf16x8*)kr, k1 = *(const bf16x8*)(kr + 32);
        f32x4 z4 = {0.f, 0.f, 0.f, 0.f};
        z4 = __builtin_amdgcn_mfma_f32_16x16x32_bf16(k0, qf[0], z4, 0, 0, 0);
        sc[kt] = __builtin_amdgcn_mfma_f32_16x16x32_bf16(k1, qf[1], z4, 0, 0, 0); }
    const int a = 16 * w + fr;
    float mx = -1e30f;
#pragma unroll
    for (int kt = 0; kt < 9; ++kt)
#pragma unroll
        for (int rg = 0; rg < 4; ++rg) { const int cidx = 16 * (w + kt) + 4 * quad + rg, rel = cidx - 64 - a, ik = 128 * jb - 64 + cidx;
            const bool valid = (rel >= -64) && (rel <= 64) && (ik >= 0) && (ik < n);
            const int bi = rel < -64 ? 0 : (rel > 64 ? 128 : rel + 64);
            const float s = valid ? sc[kt][rg] * 0.125f + bt[bi] : -1e30f;
            sc[kt][rg] = s; mx = fmaxf(mx, s); }
    mx = fmaxf(mx, __shfl_xor(mx, 16)); mx = fmaxf(mx, __shfl_xor(mx, 32));
    float lsum = 0.f;
#pragma unroll
    for (int kt = 0; kt < 9; ++kt)
#pragma unroll
        for (int rg = 0; rg < 4; ++rg) { const float s = sc[kt][rg]; const float p = (s > -1e29f) ? __expf(s - mx) : 0.f; sc[kt][rg] = p; lsum += p; }
    lsum += __shfl_xor(lsum, 16); lsum += __shfl_xor(lsum, 32);
    f32x4 oo[4];
#pragma unroll
    for (int dt = 0; dt < 4; ++dt) oo[dt] = (f32x4){0.f, 0.f, 0.f, 0.f};
#pragma unroll
    for (int pp = 0; pp < 5; ++pp) { const int ktA = 2 * pp, ktB = 2 * pp + 1, ktBc = ktB < 9 ? ktB : 8;
        union { bf16x8 v; unsigned u[4]; } pf;
        pf.u[0] = cvt_pk_bf16(sc[ktA][0], sc[ktA][1]); pf.u[1] = cvt_pk_bf16(sc[ktA][2], sc[ktA][3]);
        if (ktB < 9) { pf.u[2] = cvt_pk_bf16(sc[ktBc][0], sc[ktBc][1]); pf.u[3] = cvt_pk_bf16(sc[ktBc][2], sc[ktBc][3]); } else { pf.u[2] = 0u; pf.u[3] = 0u; }
#pragma unroll
        for (int dt = 0; dt < 4; ++dt) { const bf16_t* vr = Vs + (16 * w + 4 * quad + (fr >> 2)) * 72 + 16 * dt + 4 * (fr & 3);
            union { bf16x8 v; s16x4_t h[2]; } vf; vf.h[0] = lds_tr_b64(vr + 16 * ktA * 72); vf.h[1] = lds_tr_b64(vr + 16 * ktBc * 72);
            oo[dt] = __builtin_amdgcn_mfma_f32_16x16x32_bf16(vf.v, pf.v, oo[dt], 0, 0, 0); } }
    const float inv = 1.0f / lsum;
    const size_t tok = (size_t)(b * SEQ + r + dil * (128 * jb + a));
    __syncthreads();
#pragma unroll
    for (int dt = 0; dt < 4; ++dt) { u32x2 o; o.x = cvt_pk_bf16(oo[dt][0] * inv, oo[dt][1] * inv); o.y = cvt_pk_bf16(oo[dt][2] * inv, oo[dt][3] * inv);
        *(u32x2*)(pd + tok * 2304 + hq * 64 + 16 * dt + 4 * quad) = o; }
    if (quad == 0) C.fp(OFF_LSE)[((size_t)g * M_TOK + tok) * 4 + (hq & 3)] = mx + __logf(lsum);
}
__device__ __forceinline__ void attn_combine(const Ctx& C) {
    const bf16_t* pd = C.bfp(OFF_PROJD); const float* lse = C.fp(OFF_LSE); bf16_t* yd = C.bfp(OFF_YD);
    for (int idx = C.bid * NTHR + C.tid; idx < M_TOK * 32; idx += C.G * NTHR) {
        const int tok = idx >> 5, j = (idx >> 3) & 3, c8 = idx & 7;
        const float l0 = lse[((size_t)0 * M_TOK + tok) * 4 + j], l1 = lse[((size_t)1 * M_TOK + tok) * 4 + j], l2 = lse[((size_t)2 * M_TOK + tok) * 4 + j];
        const float mx = fmaxf(l0, fmaxf(l1, l2)); float w0 = __expf(l0 - mx), w1 = __expf(l1 - mx), w2 = __expf(l2 - mx); const float inv = 1.0f / (w0 + w1 + w2); w0 *= inv; w1 *= inv; w2 *= inv;
        const bf16_t* row = pd + (size_t)tok * 2304 + j * 64 + c8 * 8;
        const u32x4 o0 = *(const u32x4*)row, o1 = *(const u32x4*)(row + 256), o2 = *(const u32x4*)(row + 512);
        u32x4 o;
        o.x = cvt_pk_bf16(w0 * bflo(o0.x) + w1 * bflo(o1.x) + w2 * bflo(o2.x), w0 * bfhi(o0.x) + w1 * bfhi(o1.x) + w2 * bfhi(o2.x));
        o.y = cvt_pk_bf16(w0 * bflo(o0.y) + w1 * bflo(o1.y) + w2 * bflo(o2.y), w0 * bfhi(o0.y) + w1 * bfhi(o1.y) + w2 * bfhi(o2.y));
        o.z = cvt_pk_bf16(w0 * bflo(o0.z) + w1 * bflo(o1.z) + w2 * bflo(o2.z), w0 * bfhi(o0.z) + w1 * bfhi(o1.z) + w2 * bfhi(o2.z));
        o.w = cvt_pk_bf16(w0 * bflo(o0.w) + w1 * bflo(o1.w) + w2 * bflo(o2.w), w0 * bfhi(o0.w) + w1 * bfhi(o1.w) + w2 * bfhi(o2.w));
        *(u32x4*)(yd + (size_t)tok * 256 + j * 64 + c8 * 8) = o;
    }
}

__global__ void __launch_bounds__(NTHR, 2) fwd_megakernel(Params prm) {
    extern __shared__ __attribute__((aligned(16))) unsigned char shm[];
    cg::grid_group grid = cg::this_grid();
    Ctx C;
    C.P = &prm;
    C.out = prm.out; C.ws = prm.ws; C.bid = blockIdx.x; C.G = gridDim.x; C.lds = shm;
#define FRESH() do { int _t = threadIdx.x; asm volatile("" : "+v"(_t)); C.tid = _t; C.lane = _t & 63; C.wave = __builtin_amdgcn_readfirstlane(_t >> 6); size_t _z = 0; asm volatile("" : "+s"(_z)); C.ws = prm.ws + _z; C.out = prm.out + _z; } while (0)
    FRESH();
    LAS unsigned char* ldsg = (LAS unsigned char*)shm;
    volatile LAS unsigned* xst = (volatile LAS unsigned*)(ldsg + (LDS_BYTES - 16));
    if (threadIdx.x == 0) { xst[0] = 0u; xst[1] = 0u; }
    __syncthreads();
    const XcdBarrier xbar = xcd_barrier_post((unsigned*)(prm.ws + OFF_BAR), xst);
#define GSYNC() do { xcd_barrier(xbar); FRESH(); } while (0)
    const int G = C.G, bid = C.bid;

    for (int l = 0; l < 2; ++l) {
        const float* xin = (l == 0) ? C.P->in[0] : C.out;
        FRESH();
        for (int _m = 0; _m < REP_MIXC; ++_m) phase_p0(C, l, xin);
        if (l == 0) { grid.sync(); FRESH(); } else GSYNC();
        for (int _g = 0; _g < REP_GEMM; ++_g) { pg8::Gemm g{C.bfp(OFF_H), C.bfp(OFF_WIN), M_TOK, INW, 1024}; pg8::StaticOrder S; S.init(M_TOK, INW, G, bid);
          pg8::EpiProj E{C.bfp(OFF_PROJA), C.bfp(OFF_PROJB), C.bfp(OFF_PROJC), C.bfp(OFF_PROJD)};
          pg8::gemm_phase<pg8::EpiProj, pg8::StaticOrder, true, true>(ldsg, g, S, E); }
        GSYNC();
        FRESH();
        { u32x4 akv[4], avv[4], aqv[2]; attn_fetch(C, bid, akv, avv, aqv);
          for (int it = bid; it < 3072; it += G) attn_item(C, it, it + G, akv, avv, aqv); }
        __syncthreads();
        FRESH();
        for (int _m = 0; _m < REP_MIXA; ++_m) for (int it = bid; it < 512; it += G) lru_item<false>(C, l, it);
        FRESH();
        for (int _m = 0; _m < REP_MIXB; ++_m) for (int it = bid * 8 + C.wave; it < 2048; it += G * 8) hgrn_pass1_item(C, l, it);
        __syncthreads();
        FRESH();
        for (int _m = 0; _m < REP_MIXC; ++_m) for (int it = bid * 8 + C.wave; it < 6144; it += G * 8) hy_tr_item(C, l, it);
        GSYNC();
        FRESH();
        hgrn_scan(C); lru_scan(C);
        GSYNC();
        FRESH();
        for (int _m = 0; _m < REP_HYC; ++_m) for (int c = bid; c < 256; c += G) hy_conv_item(C, l, c);
        __syncthreads();
        FRESH();
        for (int _m = 0; _m < REP_MIXB; ++_m) for (int it = bid * 8 + C.wave; it < 1024; it += G * 8) hgrn_pass3_item<1>(C, l, it);
        __syncthreads();
        FRESH();
        for (int _m = 0; _m < REP_MIXA; ++_m) for (int it = bid; it < 512; it += G) lru_item<true>(C, l, it);
        GSYNC();
        FRESH();
        for (int it = bid * 8 + C.wave; it < 1024; it += G * 8) hgrn_pass3_item<0>(C, l, it);
        __syncthreads();
        for (int _m = 0; _m < REP_MIXC; ++_m) { for (int it = bid * 8 + C.wave; it < 2048; it += G * 8) hy_out_tr_item(C, it);
        FRESH();
        attn_combine(C); }
        GSYNC();
        for (int _g = 0; _g < REP_GEMM; ++_g) for (int j = 0; j < 4; ++j) {
            const bf16_t* yj = (j == 0) ? C.bfp(OFF_YA) : (j == 1) ? C.bfp(OFF_YB) : (j == 2) ? C.bfp(OFF_YC) : C.bfp(OFF_YD);
            pg8::Gemm g{yj, C.bfp(OFF_WBR) + (size_t)j * 1024 * 256, M_TOK, 1024, 256}; pg8::StaticOrder S; S.init(M_TOK, 1024, G, bid);
            pg8::EpiBf16 E{C.bfp(OFF_P) + j * 1024, 4096};
            pg8::gemm_phase(ldsg, g, S, E);
        }
        GSYNC();
        for (int _g = 0; _g < REP_GEMM; ++_g) { pg8::Gemm g{C.bfp(OFF_H), C.bfp(OFF_WGATE), M_TOK, 4096, 1024}; pg8::GateOrder S{G, bid};
          pg8::EpiGate E{C.bfp(OFF_P), C.bfp(OFF_MIXED), C.P->in[24] + (size_t)l * 4096};
          pg8::gemm_phase<pg8::EpiGate, pg8::GateOrder, true, true>(ldsg, g, S, E); }
        GSYNC();
        { pg8::Gemm g{C.bfp(OFF_MIXED), C.bfp(OFF_WOUT), M_TOK, 1024, 1024}; pg8::StaticOrder S; S.init(M_TOK, 1024, G, bid);
          pg8::EpiRes E{xin, C.out};
          pg8::gemm_phase<pg8::EpiRes, pg8::StaticOrder, true, true>(ldsg, g, S, E); }
        GSYNC();
        FRESH();
        for (int row = bid * 8 + C.wave; row < M_TOK; row += 2 * G * 8) rms_row2_bf16(C.out + (size_t)row * 1024, (size_t)G * 8 * 1024, C.P->in[26] + l * 1024, C.bfp(OFF_H) + (size_t)row * 1024, C.lane);
        GSYNC();
        for (int _g = 0; _g < REP_GEMM; ++_g) { pg8::Gemm g{C.bfp(OFF_H), C.bfp(OFF_WFF13), M_TOK, 2 * DFF, 1024}; pg8::StaticOrder S; S.init(M_TOK, 2 * DFF, G, bid);
          pg8::EpiSwiglu E{C.bfp(OFF_U)};
          pg8::gemm_phase<pg8::EpiSwiglu, pg8::StaticOrder, true, true>(ldsg, g, S, E); }
        GSYNC();
        { pg8::Gemm g{C.bfp(OFF_U), C.bfp(OFF_WFF2), M_TOK, 1024, DFF}; pg8::StaticOrder S; S.init(M_TOK, 1024, G, bid);
          pg8::EpiRes E{C.out, C.out};
          pg8::gemm_phase<pg8::EpiRes, pg8::StaticOrder, true, true>(ldsg, g, S, E); }
        GSYNC();
    }
    FRESH();
    for (int row = bid * 8 + C.wave; row < M_TOK; row += G * 8) rms_row_f32(C.out + (size_t)row * 1024, C.P->in[30], C.lane);
}

extern "C" void kernel_launch(void* const* d_in, const int* in_sizes, int n_in, void* d_out, int out_size, void* d_ws, size_t ws_size, hipStream_t stream) {
    static int grid_blocks = 0;
    if (!grid_blocks) {
        if (n_in != 31 || ws_size < WS_END) { fprintf(stderr, "kernel_launch: unexpected n_in %d or ws_size %zu (< %zu)\n", n_in, ws_size, (size_t)WS_END); }
        int dev = 0, cus = 0, per_cu = 0;
        hipGetDevice(&dev);
        hipDeviceGetAttribute(&cus, hipDeviceAttributeMultiprocessorCount, dev);
        hipFuncSetAttribute((const void*)fwd_megakernel, hipFuncAttributeMaxDynamicSharedMemorySize, LDS_BYTES);
        hipOccupancyMaxActiveBlocksPerMultiprocessor(&per_cu, (const void*)fwd_megakernel, NTHR, LDS_BYTES);
        if (per_cu < 1) per_cu = 1;
        grid_blocks = cus * per_cu;
        (void)hipGetLastError();
    }
    Params p{};
    for (int i = 0; i < 31; ++i) p.in[i] = (const float*)d_in[i];
    p.out = (float*)d_out; p.ws = (unsigned char*)d_ws;
    hipMemsetAsync((unsigned char*)d_ws + OFF_BAR, 0, 16384, stream);
    void* args[] = {&p};
    hipError_t e = hipLaunchCooperativeKernel((const void*)fwd_megakernel, dim3(grid_blocks), dim3(NTHR), args, LDS_BYTES, stream);
    if (e != hipSuccess) fprintf(stderr, "cooperative launch failed: %s (grid %d)\n", hipGetErrorString(e), grid_blocks);
}
```

```cpp
#include <hip/hip_runtime.h>
#include <hip/hip_cooperative_groups.h>
#include <cstdio>
#include <cstdint>
namespace cg = cooperative_groups;

#define LAS __attribute__((address_space(3)))
typedef unsigned short bf16_t;
typedef short bf16x8 __attribute__((ext_vector_type(8)));
typedef float f32x4 __attribute__((ext_vector_type(4)));
typedef float f32x16 __attribute__((ext_vector_type(16)));
typedef unsigned u32x4 __attribute__((ext_vector_type(4)));
typedef unsigned u32x2 __attribute__((ext_vector_type(2)));

constexpr int M_TOK = 32768, SEQ = 4096, NB = 8, DM = 1024, DFF = 2816, INW = 4864;
constexpr int NTHR = 512;
#ifndef REP_SYNC
#define REP_SYNC 1
#endif
#ifndef REP_GEMM
#define REP_GEMM 1
#endif
#ifndef REP_MIXA
#define REP_MIXA 1
#endif
#ifndef REP_MIXB
#define REP_MIXB 1
#endif
#ifndef REP_MIXC
#define REP_MIXC 1
#endif
#ifndef REP_HYC
#define REP_HYC 1
#endif
constexpr int LDS_BYTES = 159744;

constexpr size_t SZ_H = (size_t)M_TOK * 1024 * 2;
constexpr size_t OFF_H = 0;
constexpr size_t OFF_R = OFF_H + SZ_H;
constexpr size_t OFF_PROJC = OFF_R;
constexpr size_t OFF_PROJA = OFF_PROJC + (size_t)M_TOK * 768 * 2;
constexpr size_t OFF_PROJB = OFF_PROJA + (size_t)M_TOK * 1280 * 2;
constexpr size_t OFF_PROJD = OFF_PROJB + (size_t)M_TOK * 512 * 2;
constexpr size_t OFF_REND = OFF_PROJD + (size_t)M_TOK * 2304 * 2;
constexpr size_t OFF_YA = OFF_PROJC;
constexpr size_t OFF_YB = OFF_YA + (size_t)M_TOK * 256 * 2;
constexpr size_t OFF_YC = OFF_YB + (size_t)M_TOK * 256 * 2;
constexpr size_t OFF_P = OFF_PROJA;
constexpr size_t OFF_U = OFF_PROJA;
constexpr size_t OFF_UCT = OFF_REND;
constexpr size_t OFF_LSE = OFF_UCT + (size_t)768 * M_TOK * 2;
constexpr size_t OFF_S = OFF_LSE + (size_t)3 * M_TOK * 4 * 4;
constexpr size_t OFF_YD = OFF_S + (size_t)1024 * 4096 * 4;
constexpr size_t OFF_MIXED = OFF_UCT;
constexpr size_t OFF_W = OFF_S + (size_t)2048 * 4096 * 4;
constexpr size_t OFF_WIN = OFF_W;
constexpr size_t OFF_WGATE = OFF_WIN + (size_t)4864 * 1024 * 2;
constexpr size_t OFF_WBR = OFF_WGATE + (size_t)4096 * 1024 * 2;
constexpr size_t OFF_WOUT = OFF_WBR + (size_t)4 * 1024 * 256 * 2;
constexpr size_t OFF_WFF13 = OFF_WOUT + (size_t)1024 * 1024 * 2;
constexpr size_t OFF_WFF2 = OFF_WFF13 + (size_t)5632 * 1024 * 2;
constexpr size_t OFF_HDN = OFF_WFF2 + (size_t)1024 * 2816 * 2;
constexpr size_t OFF_CARA = OFF_HDN + (size_t)4096 * 64 * 4;
constexpr size_t OFF_CARH = OFF_CARA + (size_t)2 * 8 * 64 * 256 * 4;
constexpr size_t OFF_DEC = OFF_CARH + (size_t)2 * 8 * 64 * 256 * 4;
constexpr size_t OFF_BAR = OFF_DEC + (size_t)2048 * 64 * 4;
constexpr size_t OFF_YCT = OFF_BAR + 16384;
constexpr size_t WS_END = OFF_YCT + (size_t)256 * M_TOK * 2;
static_assert(OFF_P + (size_t)M_TOK * 4096 * 2 == OFF_REND, "P fit");
static_assert(WS_END <= (size_t)536870912, "workspace over 512 MiB");

struct Params { const float* in[31]; float* out; unsigned char* ws; };

typedef __bf16 bf2_t __attribute__((ext_vector_type(2)));
typedef float f32x2_t __attribute__((ext_vector_type(2)));
__device__ __forceinline__ unsigned cvt_pk_bf16(float lo, float hi) { f32x2_t v = {lo, hi}; bf2_t r = __builtin_convertvector(v, bf2_t); return __builtin_bit_cast(unsigned, r); }
__device__ __forceinline__ bf16_t f2bf(float f) { return (bf16_t)(cvt_pk_bf16(f, 0.f) & 0xffffu); }
__device__ __forceinline__ float bf2f(bf16_t b) { return __uint_as_float(((unsigned)b) << 16); }
__device__ __forceinline__ float bflo(unsigned u) { return __uint_as_float(u << 16); }
__device__ __forceinline__ float bfhi(unsigned u) { return __uint_as_float(u & 0xffff0000u); }
__device__ __forceinline__ float sigmoidf_(float x) { return 1.0f / (1.0f + __expf(-x)); }
__device__ __forceinline__ float siluf_(float x) { return x * sigmoidf_(x); }
__device__ __forceinline__ float geluf_(float x) { const float y = 0.7978845608028654f * (x + 0.044715f * x * x * x); const float t = 1.0f - 2.0f / (1.0f + __expf(2.0f * y)); return 0.5f * x * (1.0f + t); }
__device__ __forceinline__ float wave_sum(float v) {
#pragma unroll
    for (int o = 1; o < 64; o <<= 1) v += __shfl_xor(v, o);
    return v;
}
typedef short s16x4_t __attribute__((ext_vector_type(4)));
__device__ __forceinline__ s16x4_t lds_tr_b64(const bf16_t* p) { return __builtin_amdgcn_ds_read_tr16_b64_v4i16((LAS s16x4_t*)p); }
__device__ __forceinline__ void wave_lds_fence() { asm volatile("s_waitcnt lgkmcnt(0)" ::: "memory"); __builtin_amdgcn_wave_barrier(); }

#define XB_TMO      128
#define XB_XCNT(j)  (256  + 64 * (j))
#define XB_XSUB(j)  (1280 + 64 * (j))
#define XB_XGEN(j)  (2304 + 64 * (j))
#define XB_TOP      3328
#define XB_TOPGEN   3392
#define XCD_BAR_WORDS 3456
#define XB_SPIN_CAP (1u << 22)
__device__ __forceinline__ unsigned xb_ld(unsigned* p)              { return __hip_atomic_load(p, __ATOMIC_RELAXED, __HIP_MEMORY_SCOPE_AGENT); }
__device__ __forceinline__ unsigned xb_add(unsigned* p, unsigned v) { return __hip_atomic_fetch_add(p, v, __ATOMIC_RELAXED, __HIP_MEMORY_SCOPE_AGENT); }
__device__ __forceinline__ unsigned xb_xcc_id() { return (unsigned)__builtin_amdgcn_s_getreg((3 << 11) | 20) & 0xFu; }
#define XB_SPIN(cond, bar) do { unsigned _sp = 0; while (cond) { __builtin_amdgcn_s_sleep(1); \
    if ((++_sp & 255u) == 0u) { if (xb_ld(&(bar)[XB_TMO])) break; if (_sp > XB_SPIN_CAP) { atomicAdd(&(bar)[XB_TMO], 1u); break; } } } } while (0)
struct XcdBarrier { unsigned* bar; unsigned x; volatile LAS unsigned* st; };
__device__ __forceinline__ XcdBarrier xcd_barrier_post(unsigned* bar, volatile LAS unsigned* st) {
    XcdBarrier b; b.bar = bar; b.x = xb_xcc_id(); b.st = st;
    if (threadIdx.x == 0) (void)xb_add(&bar[XB_XCNT(b.x)], 1u);
    return b;
}
__device__ __forceinline__ void xcd_barrier_complete(unsigned* bar, unsigned x, unsigned& nloc, unsigned& nx) {
    const unsigned G = gridDim.x * gridDim.y * gridDim.z;
    unsigned sum, cnt, mine, sp = 0u;
    for (;;) {
        sum = 0u; cnt = 0u; mine = 0u;
#pragma unroll
        for (unsigned j = 0; j < 16; ++j) { const unsigned c = xb_ld(&bar[XB_XCNT(j)]); sum += c; cnt += (c > 0u) ? 1u : 0u; mine = (j == x) ? c : mine; }
        if (sum == G) break;
        __builtin_amdgcn_s_sleep(1);
        if ((++sp & 255u) == 0u) { if (xb_ld(&bar[XB_TMO])) break; if (sp > XB_SPIN_CAP) { atomicAdd(&bar[XB_TMO], 1u); break; } }
    }
    nloc = mine > 0u ? mine : 1u; nx = cnt > 0u ? cnt : 1u;
}
__device__ __forceinline__ void xcd_barrier(const XcdBarrier& b) {
    asm volatile("s_waitcnt vmcnt(0)" ::: "memory");
    __syncthreads();
    if (threadIdx.x == 0) {
        unsigned* bar = b.bar;
        __builtin_amdgcn_s_waitcnt(0);
        unsigned nloc = b.st[0], nx = b.st[1];
        if (nloc == 0u) { xcd_barrier_complete(bar, b.x, nloc, nx); b.st[0] = nloc; b.st[1] = nx; }
        const unsigned old = xb_add(&bar[XB_XSUB(b.x)], 1u);
        const unsigned gen = old / nloc;
        if (old + 1u == (gen + 1u) * nloc) {
            __builtin_amdgcn_fence(__ATOMIC_RELEASE, "agent");
            asm volatile("s_waitcnt vmcnt(0)" ::: "memory");
            const unsigned og = xb_add(&bar[XB_TOP], 1u);
            const unsigned tg = og / nx;
            if (og + 1u == (tg + 1u) * nx) xb_add(&bar[XB_TOPGEN], 1u);
            else XB_SPIN(xb_ld(&bar[XB_TOPGEN]) == tg, bar);
            __builtin_amdgcn_fence(__ATOMIC_ACQUIRE, "agent");
            xb_add(&bar[XB_XGEN(b.x)], 1u);
            asm volatile("s_waitcnt vmcnt(0)" ::: "memory");
        } else {
            XB_SPIN(xb_ld(&bar[XB_XGEN(b.x)]) == gen, bar);
            __builtin_amdgcn_fence(__ATOMIC_ACQUIRE, "agent");
            asm volatile("s_waitcnt vmcnt(0)" ::: "memory");
        }
    }
    __syncthreads();
}

namespace pg8 {
constexpr int BM = 256, BK = 64, HALF = 128, HTB = HALF * BK * 2, STAGE_BYTES = 8 * HTB, NXCD = 8, WGM = 8;
__host__ __device__ __forceinline__ int lds_byte(int r, int c) { const int st = (r >> 4) * 2 + (c >> 5), rr = r & 15, cc = c & 31, ob = rr * 64 + cc * 2; return st * 1024 + (ob ^ (((ob >> 9) & 1) << 5)); }
__host__ __device__ __forceinline__ void stage_rc(int b, int& R, int& C) { const int st = b / 1024, sb = b % 1024, swz = sb ^ (((sb >> 9) & 1) << 5); R = (st >> 1) * 16 + swz / 64; C = (st & 1) * 32 + (swz % 64) / 2; }
__host__ __device__ __forceinline__ int perm32(int rho) { const int n = rho >> 4, i = rho & 15; return 8 * (i >> 2) + 4 * n + (i & 3); }
struct Unit { int pm, pn; };
struct Gemm { const bf16_t* A; const bf16_t* Bt; int M, N, K; };
struct StaticOrder {
    int nM, nN, nwg, G, c;
    __device__ void init(int M, int N, int G_, int c_) { nM = M / BM; nN = N / BM; nwg = nM * nN; G = G_; c = c_; }
    __device__ bool next(int i, Unit& u) const {
        const long L = (long)i * G + c; if (L >= nwg) return false;
        int wgid = (int)L; { const int q = nwg / NXCD, r = nwg % NXCD, xcd = wgid % NXCD, off = wgid / NXCD; wgid = (xcd < r ? xcd * (q + 1) : r * (q + 1) + (xcd - r) * q) + off; }
        const int nig = WGM * nN, gid = wgid / nig, fm = gid * WGM, gsz = (nM - fm) < WGM ? (nM - fm) : WGM;
        u.pm = fm + ((wgid % nig) % gsz); u.pn = (wgid % nig) / gsz; return true;
    }
};
struct GateOrder {
    int G, c;
    __device__ bool next(int i, Unit& u) const {
        const int su = (i >> 2) * G + c; if (su >= 512) return false;
        u.pm = su >> 2; u.pn = (i & 3) * 4 + (su & 3); return true;
    }
};

template <class Epi, class Sched, bool ALIGN_EPI = false, bool SP2 = false>
__device__ __forceinline__ void gemm_phase(LAS unsigned char* lds, const Gemm g, const Sched& S, const Epi& E) {
    int tid = threadIdx.x; asm volatile("" : "+v"(tid));
    const int wid = __builtin_amdgcn_readfirstlane(tid >> 6), lane = tid & 63, wr = wid >> 2, wc = wid & 3, fr = lane & 15, fq = lane >> 4;
    const int K = g.K, nt = K / BK;
    unsigned voffA[2], voffB[2];
#pragma unroll
    for (int i = 0; i < 2; ++i) { int R, C; stage_rc(tid * 16 + i * 8192, R, C); const int Rb = Epi::PERM ? ((R & ~31) + perm32(R & 31)) : R;
        voffA[i] = (unsigned)(R * K + C) * 2u; voffB[i] = (unsigned)(Rb * K + C) * 2u; }
    const size_t kstep = (size_t)(BK * 2);
    const size_t hstep = (size_t)HALF * K * 2;
    const size_t tstep = 2 * hstep;
    const unsigned ldsw = (unsigned)wid * 1024u;
    const int aoff = lds_byte(wr * 64 + fr, fq * 8), boff = lds_byte(wc * 32 + fr, fq * 8);
#define PG8_SA(b, h) (((b) * 2 + (h)) * HTB)
#define PG8_SB(b, h) ((4 + (b) * 2 + (h)) * HTB)
#define PG8_STAGE(bufoff, gbase, voff) do { _Pragma("unroll") for (int _i = 0; _i < 2; ++_i) \
        __builtin_amdgcn_global_load_lds((const unsigned*)((const char*)(gbase) + (voff)[_i]), (LAS unsigned*)(lds + (bufoff) + ldsw + _i * 8192), 16, 0, 0); } while (0)
#define PG8_LDA(dst, b, h) do { _Pragma("unroll") for (int m = 0; m < 4; ++m) _Pragma("unroll") for (int k = 0; k < 2; ++k) dst[m][k] = *(const LAS bf16x8*)(lds + PG8_SA(b, h) + aoff + m * 2048 + k * 1024); } while (0)
#define PG8_LDB(dst, b, h) do { _Pragma("unroll") for (int n = 0; n < 2; ++n) _Pragma("unroll") for (int k = 0; k < 2; ++k) dst[n][k] = *(const LAS bf16x8*)(lds + PG8_SB(b, h) + boff + n * 2048 + k * 1024); } while (0)
#define PG8_MMA(ai, bj, At, Bt) do { __builtin_amdgcn_s_setprio(1); _Pragma("unroll") for (int m = 0; m < 4; ++m) _Pragma("unroll") for (int n = 0; n < 2; ++n) _Pragma("unroll") for (int k = 0; k < 2; ++k) \
        acc[ai][bj][m][n] = __builtin_amdgcn_mfma_f32_16x16x32_bf16(Bt[n][k], At[m][k], acc[ai][bj][m][n], 0, 0, 0); __builtin_amdgcn_s_setprio(0); } while (0)
#define PG8_WAIT_V(n) asm volatile("s_waitcnt vmcnt(" #n ")" ::: "memory")
#define PG8_WAIT_L(n) asm volatile("s_waitcnt lgkmcnt(" #n ")" ::: "memory")
#define PG8_BAR __builtin_amdgcn_s_barrier()
#define PG8_SCHED __builtin_amdgcn_sched_barrier(0)
    Unit cur, nxt; int ui = 0;
    if (!S.next(0, cur)) return;
    f32x4 acc[2][2][4][2];
#pragma unroll
    for (int a = 0; a < 2; ++a)
#pragma unroll
        for (int b = 0; b < 2; ++b)
#pragma unroll
            for (int m = 0; m < 4; ++m)
#pragma unroll
                for (int n = 0; n < 2; ++n) acc[a][b][m][n] = (f32x4){0.f, 0.f, 0.f, 0.f};
    bf16x8 At[4][2], B0[2][2], B1[2][2];
    const char* cA = (const char*)g.A + (size_t)cur.pm * tstep; const char* cB = (const char*)g.Bt + (size_t)cur.pn * tstep;
    if constexpr (SP2) {
        PG8_STAGE(PG8_SB(0, 0), cB, voffB); PG8_STAGE(PG8_SB(0, 1), cB + hstep, voffB); PG8_STAGE(PG8_SA(0, 0), cA, voffA); PG8_STAGE(PG8_SA(0, 1), cA + hstep, voffA);
        if (wr == 1) PG8_BAR;
        PG8_WAIT_V(2); PG8_BAR;
        PG8_STAGE(PG8_SB(1, 0), cB + kstep, voffB); PG8_STAGE(PG8_SA(1, 0), cA + kstep, voffA); PG8_STAGE(PG8_SB(1, 1), cB + hstep + kstep, voffB);
        PG8_WAIT_V(6); PG8_BAR;
    } else {
        PG8_STAGE(PG8_SB(0, 0), cB, voffB); PG8_STAGE(PG8_SA(0, 0), cA, voffA); PG8_STAGE(PG8_SB(0, 1), cB + hstep, voffB); PG8_STAGE(PG8_SA(0, 1), cA + hstep, voffA);
        if (wr == 1) PG8_BAR;
        PG8_WAIT_V(4); PG8_BAR;
        PG8_STAGE(PG8_SB(1, 0), cB + kstep, voffB); PG8_STAGE(PG8_SA(1, 0), cA + kstep, voffA); PG8_STAGE(PG8_SB(1, 1), cB + hstep + kstep, voffB);
        PG8_WAIT_V(6); PG8_BAR;
    }
    for (;;) {
        const bool has_next = S.next(ui + 1, nxt);
        const char* nA = has_next ? (const char*)g.A + (size_t)nxt.pm * tstep : cA; const char* nB = has_next ? (const char*)g.Bt + (size_t)nxt.pn * tstep : cB;
        for (int t = 0; t < nt; t += 2) {
            const bool last = (t == nt - 2);
            const char* a1 = cA + (size_t)(t + 1) * kstep;
            const char* a2 = last ? nA : cA + (size_t)(t + 2) * kstep; const char* b2 = last ? nB : cB + (size_t)(t + 2) * kstep;
            const char* a3 = a2 + kstep; const char* b3 = b2 + kstep;
            if constexpr (SP2) {
            PG8_LDB(B0, 0, 0); PG8_LDB(B1, 0, 1); PG8_SCHED; PG8_LDA(At, 0, 0); PG8_STAGE(PG8_SA(1, 1), a1 + hstep, voffA);
            PG8_WAIT_V(8); PG8_WAIT_L(0); PG8_BAR; PG8_MMA(0, 0, At, B0); PG8_MMA(0, 1, At, B1); PG8_BAR; PG8_SCHED;
            PG8_LDA(At, 0, 1); PG8_STAGE(PG8_SB(0, 0), b2, voffB); PG8_STAGE(PG8_SB(0, 1), b2 + hstep, voffB); PG8_STAGE(PG8_SA(0, 0), a2, voffA);
            PG8_WAIT_V(8); PG8_WAIT_L(0); PG8_BAR; PG8_MMA(1, 0, At, B0); PG8_MMA(1, 1, At, B1); PG8_BAR; PG8_SCHED;
            PG8_LDB(B0, 1, 0); PG8_LDB(B1, 1, 1); PG8_SCHED; PG8_LDA(At, 1, 0); PG8_STAGE(PG8_SA(0, 1), a2 + hstep, voffA);
            PG8_WAIT_V(8); PG8_WAIT_L(0); PG8_BAR; PG8_MMA(0, 0, At, B0); PG8_MMA(0, 1, At, B1); PG8_BAR; PG8_SCHED;
            PG8_LDA(At, 1, 1); PG8_STAGE(PG8_SB(1, 0), b3, voffB); PG8_STAGE(PG8_SB(1, 1), b3 + hstep, voffB); PG8_STAGE(PG8_SA(1, 0), a3, voffA);
            PG8_WAIT_V(8); PG8_WAIT_L(0); PG8_BAR; PG8_MMA(1, 0, At, B0); PG8_MMA(1, 1, At, B1); PG8_BAR; PG8_SCHED;
            } else {
            PG8_LDB(B0, 0, 0); PG8_SCHED; PG8_LDA(At, 0, 0); PG8_STAGE(PG8_SA(1, 1), a1 + hstep, voffA);
            PG8_WAIT_L(8); PG8_BAR; PG8_WAIT_L(0); PG8_MMA(0, 0, At, B0); PG8_BAR; PG8_SCHED;
            PG8_LDB(B1, 0, 1); PG8_STAGE(PG8_SB(0, 0), b2, voffB);
            PG8_BAR; PG8_WAIT_L(0); PG8_MMA(0, 1, At, B1); PG8_BAR;
            PG8_LDA(At, 0, 1); PG8_STAGE(PG8_SA(0, 0), a2, voffA);
            PG8_BAR; PG8_WAIT_L(0); PG8_MMA(1, 0, At, B0); PG8_BAR; PG8_SCHED;
            PG8_STAGE(PG8_SB(0, 1), b2 + hstep, voffB);
            PG8_WAIT_V(6); PG8_BAR; PG8_MMA(1, 1, At, B1); PG8_BAR;
            PG8_LDB(B0, 1, 0); PG8_SCHED; PG8_LDA(At, 1, 0); PG8_STAGE(PG8_SA(0, 1), a2 + hstep, voffA);
            PG8_WAIT_L(8); PG8_BAR; PG8_WAIT_L(0); PG8_MMA(0, 0, At, B0); PG8_BAR; PG8_SCHED;
            PG8_LDB(B1, 1, 1); PG8_STAGE(PG8_SB(1, 0), b3, voffB);
            PG8_BAR; PG8_WAIT_L(0); PG8_MMA(0, 1, At, B1); PG8_BAR;
            PG8_LDA(At, 1, 1); PG8_STAGE(PG8_SA(1, 0), a3, voffA);
            PG8_BAR; PG8_WAIT_L(0); PG8_MMA(1, 0, At, B0); PG8_BAR; PG8_SCHED;
            PG8_STAGE(PG8_SB(1, 1), b3 + hstep, voffB);
            PG8_WAIT_V(6); PG8_BAR; PG8_MMA(1, 1, At, B1); PG8_BAR;
            }
        }
        if constexpr (ALIGN_EPI) { if (wr == 0) PG8_BAR; }
        E(acc, cur, wr, wc, fr, fq);
        if (!has_next) break;
#pragma unroll
        for (int a = 0; a < 2; ++a)
#pragma unroll
            for (int b = 0; b < 2; ++b)
#pragma unroll
                for (int m = 0; m < 4; ++m)
#pragma unroll
                    for (int n = 0; n < 2; ++n) acc[a][b][m][n] = (f32x4){0.f, 0.f, 0.f, 0.f};
        cur = nxt; cA = nA; cB = nB; ++ui;
        if constexpr (ALIGN_EPI) { if (wr == 1) PG8_BAR; }
    }
    PG8_WAIT_V(0);
    if constexpr (!ALIGN_EPI) { if (wr == 0) PG8_BAR; }
    PG8_BAR;
#undef PG8_SA
#undef PG8_SB
#undef PG8_STAGE
#undef PG8_LDA
#undef PG8_LDB
#undef PG8_MMA
#undef PG8_WAIT_V
#undef PG8_WAIT_L
#undef PG8_BAR
#undef PG8_SCHED
}

struct EpiProj {
    static constexpr bool PERM = true;
    bf16_t *pa, *pb, *pc, *pd;
    __device__ __forceinline__ void operator()(const f32x4 (&acc)[2][2][4][2], const Unit& u, int wr, int wc, int fr, int fq) const {
        bf16_t* base; int ld, c0;
        if (u.pn < 5) { base = pa; ld = 1280; c0 = 256 * u.pn; } else if (u.pn < 7) { base = pb; ld = 512; c0 = 256 * (u.pn - 5); }
        else if (u.pn < 10) { base = pc; ld = 768; c0 = 256 * (u.pn - 7); } else { base = pd; ld = 2304; c0 = 256 * (u.pn - 10); }
        const int row0 = u.pm * BM + wr * 64 + fr, col0 = c0 + wc * 32 + 8 * fq;
#pragma unroll
        for (int ai = 0; ai < 2; ++ai)
#pragma unroll
            for (int m = 0; m < 4; ++m) { bf16_t* rowp = base + (size_t)(row0 + ai * HALF + m * 16) * ld + col0;
#pragma unroll
                for (int bj = 0; bj < 2; ++bj) { const f32x4 v0 = acc[ai][bj][m][0], v1 = acc[ai][bj][m][1];
                    u32x4 w; w.x = cvt_pk_bf16(v0[0], v0[1]); w.y = cvt_pk_bf16(v0[2], v0[3]); w.z = cvt_pk_bf16(v1[0], v1[1]); w.w = cvt_pk_bf16(v1[2], v1[3]);
                    *(u32x4*)(rowp + bj * HALF) = w; } }
    }
};
struct EpiBf16 {
    static constexpr bool PERM = true;
    bf16_t* O; int ldc;
    __device__ __forceinline__ void operator()(const f32x4 (&acc)[2][2][4][2], const Unit& u, int wr, int wc, int fr, int fq) const {
        const int row0 = u.pm * BM + wr * 64 + fr, col0 = u.pn * BM + wc * 32 + 8 * fq;
#pragma unroll
        for (int ai = 0; ai < 2; ++ai)
#pragma unroll
            for (int m = 0; m < 4; ++m) { bf16_t* rowp = O + (size_t)(row0 + ai * HALF + m * 16) * ldc + col0;
#pragma unroll
                for (int bj = 0; bj < 2; ++bj) { const f32x4 v0 = acc[ai][bj][m][0], v1 = acc[ai][bj][m][1];
                    u32x4 w; w.x = cvt_pk_bf16(v0[0], v0[1]); w.y = cvt_pk_bf16(v0[2], v0[3]); w.z = cvt_pk_bf16(v1[0], v1[1]); w.w = cvt_pk_bf16(v1[2], v1[3]);
                    *(u32x4*)(rowp + bj * HALF) = w; } }
    }
};
struct EpiGate {
    static constexpr bool PERM = true;
    const bf16_t* P; bf16_t* mixed; const float* bg;
    __device__ __forceinline__ void operator()(const f32x4 (&acc)[2][2][4][2], const Unit& u, int wr, int wc, int fr, int fq) const {
        const int j = u.pn >> 2, ct = u.pn & 3;
        const int row0 = u.pm * BM + wr * 64 + fr, colg = u.pn * BM + wc * 32 + 8 * fq, colm = ct * BM + wc * 32 + 8 * fq;
        f32x4 bv[2][2];
#pragma unroll
        for (int bj = 0; bj < 2; ++bj)
#pragma unroll
            for (int n = 0; n < 2; ++n) bv[bj][n] = *(const f32x4*)(bg + colg + bj * HALF + 4 * n);
#pragma unroll
        for (int ai = 0; ai < 2; ++ai)
#pragma unroll
            for (int m2 = 0; m2 < 2; ++m2) {
                u32x4 pvv[2][2], ovv[2][2];
#pragma unroll
                for (int mm = 0; mm < 2; ++mm) { const size_t row = (size_t)(row0 + ai * HALF + (2 * m2 + mm) * 16);
#pragma unroll
                    for (int bj = 0; bj < 2; ++bj) { pvv[mm][bj] = *(const u32x4*)(P + row * 4096 + colg + bj * HALF);
                        if (j > 0) ovv[mm][bj] = *(const u32x4*)(mixed + row * 1024 + colm + bj * HALF); else ovv[mm][bj] = (u32x4){0u, 0u, 0u, 0u}; } }
#pragma unroll
                for (int mm = 0; mm < 2; ++mm) { const int m = 2 * m2 + mm; const size_t row = (size_t)(row0 + ai * HALF + m * 16);
#pragma unroll
                    for (int bj = 0; bj < 2; ++bj) {
                        const u32x4 pv = pvv[mm][bj], ov = ovv[mm][bj];
                        bf16_t* mp = mixed + row * 1024 + colm + bj * HALF;
                        const f32x4 a0 = acc[ai][bj][m][0] + bv[bj][0], a1 = acc[ai][bj][m][1] + bv[bj][1];
                        float r[8];
                        r[0] = sigmoidf_(a0[0]) * bflo(pv.x); r[1] = sigmoidf_(a0[1]) * bfhi(pv.x); r[2] = sigmoidf_(a0[2]) * bflo(pv.y); r[3] = sigmoidf_(a0[3]) * bfhi(pv.y);
                        r[4] = sigmoidf_(a1[0]) * bflo(pv.z); r[5] = sigmoidf_(a1[1]) * bfhi(pv.z); r[6] = sigmoidf_(a1[2]) * bflo(pv.w); r[7] = sigmoidf_(a1[3]) * bfhi(pv.w);
                        r[0] += bflo(ov.x); r[1] += bfhi(ov.x); r[2] += bflo(ov.y); r[3] += bfhi(ov.y); r[4] += bflo(ov.z); r[5] += bfhi(ov.z); r[6] += bflo(ov.w); r[7] += bfhi(ov.w);
                        u32x4 w; w.x = cvt_pk_bf16(r[0], r[1]); w.y = cvt_pk_bf16(r[2], r[3]); w.z = cvt_pk_bf16(r[4], r[5]); w.w = cvt_pk_bf16(r[6], r[7]);
                        *(u32x4*)mp = w; } }
                asm volatile("" ::: "memory");
            }
    }
};
struct EpiRes {
    static constexpr bool PERM = false;
    const float* xin; float* out;
    __device__ __forceinline__ void operator()(const f32x4 (&acc)[2][2][4][2], const Unit& u, int wr, int wc, int fr, int fq) const {
        const int row0 = u.pm * BM + wr * 64 + fr, col0 = u.pn * BM + wc * 32 + 4 * fq;
#pragma unroll
        for (int ai = 0; ai < 2; ++ai)
#pragma unroll
            for (int m2 = 0; m2 < 2; ++m2) {
                f32x4 xv[2][2][2];
#pragma unroll
                for (int mm = 0; mm < 2; ++mm) { const size_t off = (size_t)(row0 + ai * HALF + (2 * m2 + mm) * 16) * 1024 + col0;
#pragma unroll
                    for (int bj = 0; bj < 2; ++bj)
#pragma unroll
                        for (int n = 0; n < 2; ++n) xv[mm][bj][n] = *(const f32x4*)(xin + off + bj * HALF + n * 16); }
#pragma unroll
                for (int mm = 0; mm < 2; ++mm) { const size_t off = (size_t)(row0 + ai * HALF + (2 * m2 + mm) * 16) * 1024 + col0;
#pragma unroll
                    for (int bj = 0; bj < 2; ++bj)
#pragma unroll
                        for (int n = 0; n < 2; ++n) *(f32x4*)(out + off + bj * HALF + n * 16) = xv[mm][bj][n] + acc[ai][bj][2 * m2 + mm][n]; }
                asm volatile("" ::: "memory");
            }
    }
};
struct EpiSwiglu {
    static constexpr bool PERM = true;
    bf16_t* U;
    __device__ __forceinline__ void operator()(const f32x4 (&acc)[2][2][4][2], const Unit& u, int wr, int wc, int fr, int fq) const {
        const int row0 = u.pm * BM + wr * 64 + fr, col0 = u.pn * HALF + wc * 32 + 8 * fq;
#pragma unroll
        for (int ai = 0; ai < 2; ++ai)
#pragma unroll
            for (int m = 0; m < 4; ++m) { bf16_t* rowp = U + (size_t)(row0 + ai * HALF + m * 16) * DFF + col0;
                const f32x4 g0 = acc[ai][0][m][0], g1 = acc[ai][0][m][1], h0 = acc[ai][1][m][0], h1 = acc[ai][1][m][1];
                u32x4 w; w.x = cvt_pk_bf16(siluf_(g0[0]) * h0[0], siluf_(g0[1]) * h0[1]); w.y = cvt_pk_bf16(siluf_(g0[2]) * h0[2], siluf_(g0[3]) * h0[3]);
                w.z = cvt_pk_bf16(siluf_(g1[0]) * h1[0], siluf_(g1[1]) * h1[1]); w.w = cvt_pk_bf16(siluf_(g1[2]) * h1[2], siluf_(g1[3]) * h1[3]);
                *(u32x4*)rowp = w; }
    }
};
}

struct Ctx {
    const Params* P; float* out; unsigned char* ws;
    int tid, lane, wave, bid, G;
    unsigned char* lds;
    __device__ __forceinline__ bf16_t* bfp(size_t off) const { return (bf16_t*)(ws + off); }
    __device__ __forceinline__ float* fp(size_t off) const { return (float*)(ws + off); }
};

__device__ __forceinline__ void tr_tile(const float* W, int N, int k0, int n0, bf16_t* WT, int ldt, int drow0, float* scr, int lane) {
#pragma unroll 8
    for (int i = 0; i < 32; ++i) { const int kk = 2 * i + (lane >> 5); scr[kk * 33 + (lane & 31)] = W[(size_t)(k0 + kk) * N + n0 + (lane & 31)]; }
    wave_lds_fence();
    const int c = lane & 7;
#pragma unroll
    for (int j = 0; j < 4; ++j) { const int n = (lane >> 3) + 8 * j; const float* s = scr + (8 * c) * 33 + n;
        u32x4 o; o.x = cvt_pk_bf16(s[0 * 33], s[1 * 33]); o.y = cvt_pk_bf16(s[2 * 33], s[3 * 33]); o.z = cvt_pk_bf16(s[4 * 33], s[5 * 33]); o.w = cvt_pk_bf16(s[6 * 33], s[7 * 33]);
        *(u32x4*)(WT + (size_t)(drow0 + n) * ldt + k0 + 8 * c) = o; }
    wave_lds_fence();
}
__device__ __forceinline__ void rms_row_bf16(const float* xrow, const float* g, bf16_t* orow, int lane) {
    const f32x4* xr = (const f32x4*)xrow + lane; const f32x4* gr = (const f32x4*)g + lane;
    f32x4 v[4]; float s = 0.f;
#pragma unroll
    for (int j = 0; j < 4; ++j) { v[j] = xr[64 * j]; s += (v[j].x * v[j].x + v[j].y * v[j].y) + (v[j].z * v[j].z + v[j].w * v[j].w); }
    const float r = rsqrtf(wave_sum(s) * (1.f / 1024.f) + 1e-6f);
    u32x2* o8 = (u32x2*)orow + lane;
#pragma unroll
    for (int j = 0; j < 4; ++j) { const f32x4 gg = gr[64 * j]; u32x2 o; o.x = cvt_pk_bf16(v[j].x * r * gg.x, v[j].y * r * gg.y); o.y = cvt_pk_bf16(v[j].z * r * gg.z, v[j].w * r * gg.w); o8[64 * j] = o; }
}
__device__ __forceinline__ void rms_row2_bf16(const float* xrow, size_t stride, const float* g, bf16_t* orow, int lane) {
    const f32x4* xr0 = (const f32x4*)xrow + lane; const f32x4* xr1 = (const f32x4*)(xrow + stride) + lane; const f32x4* gr = (const f32x4*)g + lane;
    f32x4 v0[4], v1[4]; float s0 = 0.f, s1 = 0.f;
#pragma unroll
    for (int j = 0; j < 4; ++j) { v0[j] = xr0[64 * j]; v1[j] = xr1[64 * j]; }
#pragma unroll
    for (int j = 0; j < 4; ++j) { s0 += (v0[j].x * v0[j].x + v0[j].y * v0[j].y) + (v0[j].z * v0[j].z + v0[j].w * v0[j].w); s1 += (v1[j].x * v1[j].x + v1[j].y * v1[j].y) + (v1[j].z * v1[j].z + v1[j].w * v1[j].w); }
    const float r0 = rsqrtf(wave_sum(s0) * (1.f / 1024.f) + 1e-6f), r1 = rsqrtf(wave_sum(s1) * (1.f / 1024.f) + 1e-6f);
    u32x2* o0 = (u32x2*)orow + lane; u32x2* o1 = (u32x2*)(orow + stride) + lane;
#pragma unroll
    for (int j = 0; j < 4; ++j) { const f32x4 gg = gr[64 * j]; u32x2 o; o.x = cvt_pk_bf16(v0[j].x * r0 * gg.x, v0[j].y * r0 * gg.y); o.y = cvt_pk_bf16(v0[j].z * r0 * gg.z, v0[j].w * r0 * gg.w); o0[64 * j] = o;
        u32x2 q; q.x = cvt_pk_bf16(v1[j].x * r1 * gg.x, v1[j].y * r1 * gg.y); q.y = cvt_pk_bf16(v1[j].z * r1 * gg.z, v1[j].w * r1 * gg.w); o1[64 * j] = q; }
}
__device__ __forceinline__ void rms_row_f32(float* xrow, const float* g, int lane) {
    f32x4* xr = (f32x4*)xrow + lane; const f32x4* gr = (const f32x4*)g + lane;
    f32x4 v[4]; float s = 0.f;
#pragma unroll
    for (int j = 0; j < 4; ++j) { v[j] = xr[64 * j]; s += (v[j].x * v[j].x + v[j].y * v[j].y) + (v[j].z * v[j].z + v[j].w * v[j].w); }
    const float r = rsqrtf(wave_sum(s) * (1.f / 1024.f) + 1e-6f);
#pragma unroll
    for (int j = 0; j < 4; ++j) { const f32x4 gg = gr[64 * j]; xr[64 * j] = v[j] * r * gg; }
}
__device__ __forceinline__ void hy_hdn_row(const float* w1, const float* b1, const float* fq, const float* w2, const float* b2, float* hdn2, int t, int lane) {
    const float zt = (float)t / 4095.f;
    const float w = 6.283185307179586f * (float)t / 4096.f;
    float pre = b1[lane] + zt * w1[lane];
    float w1c[16], w1s[16];
#pragma unroll
    for (int m = 0; m < 16; ++m) { w1c[m] = w1[(1 + m) * 64 + lane]; w1s[m] = w1[(17 + m) * 64 + lane]; }
#pragma unroll
    for (int m = 0; m < 16; ++m) { const float fr = 1e-4f + (float)m * ((15.f - 1e-4f) / 15.f); const float ang = fr * w;
        pre += cosf(ang) * w1c[m] - sinf(ang) * w1s[m]; }
    const float f = fq[lane];
    const float h1 = sinf(f * pre);
    float pre2 = b2[lane];
#pragma unroll 1
    for (int i0 = 0; i0 < 64; i0 += 16) { float wv[16];
#pragma unroll
        for (int i = 0; i < 16; ++i) wv[i] = w2[(i0 + i) * 64 + lane];
#pragma unroll
        for (int i = 0; i < 16; ++i) pre2 += __shfl(h1, i0 + i) * wv[i]; }
    hdn2[t * 64 + lane] = sinf(f * pre2);
}

__device__ __forceinline__ void phase_p0(const Ctx& C, int l, const float* xin) {
    float* scr = (float*)(C.lds + C.wave * 8704);
    const int gw = C.bid * 8 + C.wave, NGW = C.G * 8;
    const float* w_in = C.P->in[2] + (size_t)l * 1024 * INW; const float* w_gate = C.P->in[23] + (size_t)l * 1024 * 4096; const float* w_br = C.P->in[22] + (size_t)l * 4 * 256 * 1024;
    const float* w_out = C.P->in[25] + (size_t)l * 1024 * 1024; const float* w_ff1 = C.P->in[27] + (size_t)l * 1024 * DFF; const float* w_ff3 = C.P->in[28] + (size_t)l * 1024 * DFF; const float* w_ff2 = C.P->in[29] + (size_t)l * DFF * 1024;
    constexpr int I_IN = 16 * 152, I_G = 16 * 128, I_BR = 4 * 4 * 32, I_O = 16 * 32, I_F1 = 16 * 88, I_F2 = 44 * 32;
    constexpr int NIT = I_IN + I_G + I_BR + I_O + 2 * I_F1 + I_F2;
    for (int it = gw; it < NIT; it += NGW) {
        int r = it;
        if (r < I_IN) { const int kb = r / 152, nb = r % 152; tr_tile(w_in, INW, 64 * kb, 32 * nb, C.bfp(OFF_WIN), 1024, 32 * nb, scr, C.lane); continue; } r -= I_IN;
        if (r < I_G) { const int kb = r / 128, nb = r % 128; tr_tile(w_gate, 4096, 64 * kb, 32 * nb, C.bfp(OFF_WGATE), 1024, 32 * nb, scr, C.lane); continue; } r -= I_G;
        if (r < I_BR) { const int j = r / 128, q = r % 128, kb = q / 32, nb = q % 32; tr_tile(w_br + (size_t)j * 256 * 1024, 1024, 64 * kb, 32 * nb, C.bfp(OFF_WBR) + (size_t)j * 1024 * 256, 256, 32 * nb, scr, C.lane); continue; } r -= I_BR;
        if (r < I_O) { const int kb = r / 32, nb = r % 32; tr_tile(w_out, 1024, 64 * kb, 32 * nb, C.bfp(OFF_WOUT), 1024, 32 * nb, scr, C.lane); continue; } r -= I_O;
        if (r < 2 * I_F1) { const int which = r / I_F1, q = r % I_F1, kb = q / 88, nb = q % 88, n0 = 32 * nb;
            tr_tile(which ? w_ff3 : w_ff1, DFF, 64 * kb, n0, C.bfp(OFF_WFF13), 1024, 256 * (n0 / 128) + (n0 % 128) + 128 * which, scr, C.lane); continue; } r -= 2 * I_F1;
        { const int kb = r / 32, nb = r % 32; tr_tile(w_ff2, 1024, 64 * kb, 32 * nb, C.bfp(OFF_WFF2), DFF, 32 * nb, scr, C.lane); }
    }
    for (int row = gw; row < M_TOK; row += 2 * NGW) rms_row2_bf16(xin + (size_t)row * 1024, (size_t)NGW * 1024, C.P->in[1] + l * 1024, C.bfp(OFF_H) + (size_t)row * 1024, C.lane);
}

typedef short s16x4 __attribute__((ext_vector_type(4)));
constexpr int HPT_ = 72;
#ifndef SOFT_TR
#define SOFT_TR 0
#endif
__device__ __forceinline__ s16x4 lds_tr(const bf16_t* p) {
#if SOFT_TR
    const int fr = threadIdx.x & 15; const bf16_t* base = p - (fr >> 2) * HPT_ - 4 * (fr & 3);
    s16x4 r; r.x = (short)base[0 * HPT_ + fr]; r.y = (short)base[1 * HPT_ + fr]; r.z = (short)base[2 * HPT_ + fr]; r.w = (short)base[3 * HPT_ + fr]; return r;
#else
    return __builtin_amdgcn_ds_read_tr16_b64_v4i16((LAS s16x4*)p);
#endif
}
constexpr int HPT = 72;
template <int MODE>
__device__ __forceinline__ void hgrn_mfma(const Ctx& C, int l, int z, int b, int hd, int c, f32x4 (&Sacc)[4][4], float& dectot, unsigned char* wl, float lb) {
    const int lane = C.lane, fr = lane & 15, quad = lane >> 4;
    bf16_t* Qt = (bf16_t*)wl; bf16_t* Kb = Qt + 32 * HPT; bf16_t* Vv = Kb + 32 * HPT; float* dl = (float*)(Vv + 32 * HPT);
    const bf16_t* pa = C.bfp(OFF_PROJA); bf16_t* ya = C.bfp(OFF_YA);
    const int fcol = (z ? 512 : 256) + hd * 64 + lane, qcol = hd * 64 + lane, vcol = 768 + hd * 64 + lane;
    float gnv[4] = {0.f, 0.f, 0.f, 0.f};
    if (MODE == 2) {
#pragma unroll
        for (int vt = 0; vt < 4; ++vt) gnv[vt] = C.P->in[4][l * 256 + hd * 64 + 16 * vt + fr];
    }
#pragma unroll 1
    for (int sc = 0; sc < 4; ++sc) {
        float bacc = 0.f;
#pragma unroll 1
        for (int g8 = 0; g8 < 2; ++g8) {
            bf16_t fv[16], qv[16], vv[16];
            const int st0 = c * 128 + sc * 32 + g8 * 16; const int tq0 = z ? 4095 - st0 : st0;
            const bf16_t* row0 = pa + (size_t)(b * SEQ + tq0) * 1280; const ptrdiff_t rstep = z ? -1280 : 1280;
#pragma unroll
            for (int t = 0; t < 16; ++t) { const bf16_t* row = row0 + rstep * t; fv[t] = row[fcol]; vv[t] = row[vcol]; if (MODE != 0) qv[t] = row[qcol]; }
#pragma unroll
            for (int t = 0; t < 16; ++t) {
                const float fl = bf2f(fv[t]);
                const float sg = sigmoidf_(fl);
                const float f = lb + (1.0f - lb) * sg, kk = (1.0f - lb) * (1.0f - sg);
                bacc += __logf(fmaxf(f, 1e-30f));
                Kb[(g8 * 16 + t) * HPT + lane] = f2bf(kk * __expf(fminf(-bacc, 80.f)));
                if (MODE != 0) Qt[(g8 * 16 + t) * HPT + lane] = f2bf(bf2f(qv[t]) * __expf(fmaxf(bacc, -80.f)));
                Vv[(g8 * 16 + t) * HPT + lane] = vv[t];
            }
        }
        { const float eb = __expf(bacc); dl[lane] = eb; dectot *= eb; }
        wave_lds_fence();
        f32x4 Oacc[2][4];
        if (MODE != 0) {
            bf16x8 Sb[2][4];
#pragma unroll
            for (int ks = 0; ks < 2; ++ks)
#pragma unroll
                for (int vt = 0; vt < 4; ++vt) { union { bf16x8 v; unsigned u[4]; } t_;
                    t_.u[0] = cvt_pk_bf16(Sacc[2 * ks][vt][0], Sacc[2 * ks][vt][1]); t_.u[1] = cvt_pk_bf16(Sacc[2 * ks][vt][2], Sacc[2 * ks][vt][3]);
                    t_.u[2] = cvt_pk_bf16(Sacc[2 * ks + 1][vt][0], Sacc[2 * ks + 1][vt][1]); t_.u[3] = cvt_pk_bf16(Sacc[2 * ks + 1][vt][2], Sacc[2 * ks + 1][vt][3]); Sb[ks][vt] = t_.v; }
            float zz = 0.f; asm volatile("" : "+v"(zz));
#pragma unroll
            for (int tt = 0; tt < 2; ++tt)
#pragma unroll
                for (int vt = 0; vt < 4; ++vt) Oacc[tt][vt] = (f32x4){zz, zz, zz, zz};
#pragma unroll
            for (int tt = 0; tt < 2; ++tt)
#pragma unroll
                for (int ks = 0; ks < 2; ++ks) { const bf16_t* qp = Qt + (16 * tt + fr) * HPT + 32 * ks + 4 * quad;
                    union { bf16x8 v; u32x2 h[2]; } a_; a_.h[0] = *(const u32x2*)qp; a_.h[1] = *(const u32x2*)(qp + 16);
#pragma unroll
                    for (int vt = 0; vt < 4; ++vt) Oacc[tt][vt] = __builtin_amdgcn_mfma_f32_16x16x32_bf16(a_.v, Sb[ks][vt], Oacc[tt][vt], 0, 0, 0); }
            f32x4 P00 = {zz, zz, zz, zz}, P01 = {zz, zz, zz, zz}, P11 = {zz, zz, zz, zz};
#pragma unroll
            for (int ks = 0; ks < 2; ++ks) {
                const bf16x8 kA0 = *(const bf16x8*)(Kb + fr * HPT + 32 * ks + 8 * quad), kA1 = *(const bf16x8*)(Kb + (16 + fr) * HPT + 32 * ks + 8 * quad);
                const bf16x8 qB0 = *(const bf16x8*)(Qt + fr * HPT + 32 * ks + 8 * quad), qB1 = *(const bf16x8*)(Qt + (16 + fr) * HPT + 32 * ks + 8 * quad);
                P00 = __builtin_amdgcn_mfma_f32_16x16x32_bf16(kA0, qB0, P00, 0, 0, 0);
                P01 = __builtin_amdgcn_mfma_f32_16x16x32_bf16(kA0, qB1, P01, 0, 0, 0);
                P11 = __builtin_amdgcn_mfma_f32_16x16x32_bf16(kA1, qB1, P11, 0, 0, 0);
            }
#pragma unroll
            for (int r = 0; r < 4; ++r) if (4 * quad + r > fr) { P00[r] = 0.f; P11[r] = 0.f; }
            union { bf16x8 v; unsigned u[4]; } pa0, pa1;
            pa0.u[0] = cvt_pk_bf16(P00[0], P00[1]); pa0.u[1] = cvt_pk_bf16(P00[2], P00[3]); pa0.u[2] = 0u; pa0.u[3] = 0u;
            pa1.u[0] = cvt_pk_bf16(P01[0], P01[1]); pa1.u[1] = cvt_pk_bf16(P01[2], P01[3]); pa1.u[2] = cvt_pk_bf16(P11[0], P11[1]); pa1.u[3] = cvt_pk_bf16(P11[2], P11[3]);
#pragma unroll
            for (int vt = 0; vt < 4; ++vt) { const bf16_t* vp = Vv + (4 * quad + (fr >> 2)) * HPT + 16 * vt + 4 * (fr & 3);
                union { bf16x8 v; s16x4 h[2]; } vb; vb.h[0] = lds_tr(vp); vb.h[1] = lds_tr(vp + 16 * HPT);
                Oacc[0][vt] = __builtin_amdgcn_mfma_f32_16x16x32_bf16(pa0.v, vb.v, Oacc[0][vt], 0, 0, 0);
                Oacc[1][vt] = __builtin_amdgcn_mfma_f32_16x16x32_bf16(pa1.v, vb.v, Oacc[1][vt], 0, 0, 0); }
        }
        {
            bf16x8 vB[4];
#pragma unroll
            for (int vt = 0; vt < 4; ++vt) { const bf16_t* vp = Vv + (8 * quad + (fr >> 2)) * HPT + 16 * vt + 4 * (fr & 3);
                union { bf16x8 v; s16x4 h[2]; } vb; vb.h[0] = lds_tr(vp); vb.h[1] = lds_tr(vp + 4 * HPT); vB[vt] = vb.v; }
#pragma unroll
            for (int kt = 0; kt < 4; ++kt) { const bf16_t* kp = Kb + (8 * quad + (fr >> 2)) * HPT + 16 * kt + 4 * (fr & 3);
                union { bf16x8 v; s16x4 h[2]; } ka; ka.h[0] = lds_tr(kp); ka.h[1] = lds_tr(kp + 4 * HPT);
                const f32x4 d4 = *(const f32x4*)(dl + 16 * kt + 4 * quad);
#pragma unroll
                for (int vt = 0; vt < 4; ++vt) { Sacc[kt][vt] = __builtin_amdgcn_mfma_f32_16x16x32_bf16(ka.v, vB[vt], Sacc[kt][vt], 0, 0, 0); Sacc[kt][vt] *= d4; } }
        }
        if (MODE == 1) {
#pragma unroll
            for (int tt = 0; tt < 2; ++tt)
#pragma unroll
                for (int r = 0; r < 4; ++r) { const int st = c * 128 + sc * 32 + 16 * tt + 4 * quad + r; const int tq = z ? 4095 - st : st;
                    bf16_t* yp = ya + (size_t)(b * SEQ + tq) * 256 + hd * 64 + fr;
#pragma unroll
                    for (int vt = 0; vt < 4; ++vt) yp[16 * vt] = f2bf(Oacc[tt][vt][r]); }
        }
        if (MODE == 2) {
#pragma unroll
            for (int tt = 0; tt < 2; ++tt) {
                bf16_t tmpv[4][4], gtv[4][4];
#pragma unroll
                for (int r = 0; r < 4; ++r) { const int st = c * 128 + sc * 32 + 16 * tt + 4 * quad + r; const int tq = z ? 4095 - st : st;
                    const size_t tok = (size_t)(b * SEQ + tq); const bf16_t* yp = ya + tok * 256 + hd * 64 + fr; const bf16_t* gp = pa + tok * 1280 + 1024 + hd * 64 + fr;
#pragma unroll
                    for (int vt = 0; vt < 4; ++vt) { tmpv[r][vt] = yp[16 * vt]; gtv[r][vt] = gp[16 * vt]; } }
#pragma unroll
                for (int r = 0; r < 4; ++r) { const int st = c * 128 + sc * 32 + 16 * tt + 4 * quad + r; const int tq = z ? 4095 - st : st;
                    bf16_t* yp = ya + (size_t)(b * SEQ + tq) * 256 + hd * 64 + fr;
                    float o[4]; float ss = 0.f;
#pragma unroll
                    for (int vt = 0; vt < 4; ++vt) { o[vt] = Oacc[tt][vt][r] + bf2f(tmpv[r][vt]); ss += o[vt] * o[vt]; }
                    ss += __shfl_xor(ss, 1); ss += __shfl_xor(ss, 2); ss += __shfl_xor(ss, 4); ss += __shfl_xor(ss, 8);
                    const float rs = rsqrtf(ss * (1.f / 64.f) + 1e-6f);
#pragma unroll
                    for (int vt = 0; vt < 4; ++vt) yp[16 * vt] = f2bf(o[vt] * rs * gnv[vt] * siluf_(bf2f(gtv[r][vt]))); }
                asm volatile("" ::: "memory");
            }
        }
        wave_lds_fence();
    }
}
__device__ __forceinline__ float hgrn_lb(const Ctx& C, int l, int ch) {
    if (l == 0) return 0.f;
    const float a0 = C.P->in[3][ch], a1 = C.P->in[3][256 + ch];
    return 1.0f / (1.0f + __expf(a0 - a1));
}
__device__ __forceinline__ void hgrn_state_load(const float* sb, f32x4 (&Sacc)[4][4], int fr, int quad) {
#pragma unroll
    for (int kt = 0; kt < 4; ++kt)
#pragma unroll
        for (int vt = 0; vt < 4; ++vt)
#pragma unroll
            for (int r = 0; r < 4; ++r) Sacc[kt][vt][r] = sb[(16 * kt + 4 * quad + r) * 64 + 16 * vt + fr];
}
__device__ __forceinline__ void hgrn_pass1_item(const Ctx& C, int l, int item) {
    const int c = item & 31, hd = (item >> 5) & 3, b = (item >> 7) & 7, z = item >> 10;
    unsigned char* wl = C.lds + C.wave * 14336;
    f32x4 Sacc[4][4];
#pragma unroll
    for (int kt = 0; kt < 4; ++kt)
#pragma unroll
        for (int vt = 0; vt < 4; ++vt) Sacc[kt][vt] = (f32x4){0.f, 0.f, 0.f, 0.f};
    float dectot = 1.f;
    hgrn_mfma<0>(C, l, z, b, hd, c, Sacc, dectot, wl, hgrn_lb(C, l, hd * 64 + C.lane));
    float* sb = C.fp(OFF_S) + (size_t)item * 4096;
    const int fr = C.lane & 15, quad = C.lane >> 4;
#pragma unroll
    for (int kt = 0; kt < 4; ++kt)
#pragma unroll
        for (int vt = 0; vt < 4; ++vt)
#pragma unroll
            for (int r = 0; r < 4; ++r) sb[(16 * kt + 4 * quad + r) * 64 + 16 * vt + fr] = Sacc[kt][vt][r];
    C.fp(OFF_DEC)[item * 64 + C.lane] = dectot;
}
template <int DIR>
__device__ __forceinline__ void hgrn_pass3_item(const Ctx& C, int l, int item) {
    const int c = item & 31, hd = (item >> 5) & 3, b = item >> 7;
    unsigned char* wl = C.lds + C.wave * 14336;
    const float lb = hgrn_lb(C, l, hd * 64 + C.lane);
    const int fr = C.lane & 15, quad = C.lane >> 4;
    f32x4 Sacc[4][4]; float dectot = 1.f;
    if (DIR == 1) {
        hgrn_state_load(C.fp(OFF_S) + (size_t)((((1 * 8 + b) * 4 + hd) * 32) + (31 - c)) * 4096, Sacc, fr, quad);
        hgrn_mfma<1>(C, l, 1, b, hd, 31 - c, Sacc, dectot, wl, lb);
    } else {
        hgrn_state_load(C.fp(OFF_S) + (size_t)((((0 * 8 + b) * 4 + hd) * 32) + c) * 4096, Sacc, fr, quad);
        hgrn_mfma<2>(C, l, 0, b, hd, c, Sacc, dectot, wl, lb);
    }
}
template <int MODE>
__device__ __forceinline__ void hgrn_run(const Ctx& C, int l, int z, int b, int hd, int c, float (&S)[64], float& decp, float* wl, float lb) {
    const int lane = C.lane;
    float* F = wl; float* Q = wl + 1024; float* V = wl + 2048;
    const bf16_t* pa = C.bfp(OFF_PROJA);
    bf16_t* ya = C.bfp(OFF_YA);
    const int fcol = (z ? 512 : 256) + hd * 64 + lane, qcol = hd * 64 + lane, vcol = 768 + hd * 64 + lane, gcol = 1024 + hd * 64 + lane;
    const float gn = (MODE == 2) ? C.P->in[4][l * 256 + hd * 64 + lane] : 0.f;
    for (int sb = 0; sb < 8; ++sb) {
#pragma unroll 4
        for (int ss = 0; ss < 16; ++ss) {
            const int s = sb * 16 + ss; const int tq = z ? (4095 - (c * 128 + s)) : (c * 128 + s);
            const bf16_t* row = pa + (size_t)(b * SEQ + tq) * 1280;
            const float fl = bf2f(row[fcol]);
            const float f = lb + (1.0f - lb) * sigmoidf_(fl);
            F[ss * 64 + lane] = f; Q[ss * 64 + lane] = bf2f(row[qcol]); V[ss * 64 + lane] = bf2f(row[vcol]);
            decp *= f;
        }
        wave_lds_fence();
        for (int ss = 0; ss < 16; ++ss) {
            const float v = V[ss * 64 + lane]; float o = 0.f;
            const f32x4* F4 = (const f32x4*)(F + ss * 64); const f32x4* Q4 = (const f32x4*)(Q + ss * 64);
#pragma unroll
            for (int i4 = 0; i4 < 16; ++i4) {
                const f32x4 f4 = F4[i4];
                S[4 * i4 + 0] = fmaf(f4.x, S[4 * i4 + 0] - v, v); S[4 * i4 + 1] = fmaf(f4.y, S[4 * i4 + 1] - v, v);
                S[4 * i4 + 2] = fmaf(f4.z, S[4 * i4 + 2] - v, v); S[4 * i4 + 3] = fmaf(f4.w, S[4 * i4 + 3] - v, v);
                if (MODE != 0) { const f32x4 q4 = Q4[i4];
                    o = fmaf(q4.x, S[4 * i4 + 0], o); o = fmaf(q4.y, S[4 * i4 + 1], o); o = fmaf(q4.z, S[4 * i4 + 2], o); o = fmaf(q4.w, S[4 * i4 + 3], o); }
            }
            if (MODE != 0) {
                const int s = sb * 16 + ss; const int tq = z ? (4095 - (c * 128 + s)) : (c * 128 + s);
                const size_t tok = (size_t)(b * SEQ + tq);
                if (MODE == 1) ya[tok * 256 + hd * 64 + lane] = f2bf(o);
                else {
                    o += bf2f(ya[tok * 256 + hd * 64 + lane]);
                    const float ms = wave_sum(o * o) * (1.f / 64.f);
                    const float gate = bf2f(pa[tok * 1280 + gcol]);
                    ya[tok * 256 + hd * 64 + lane] = f2bf(o * rsqrtf(ms + 1e-6f) * gn * siluf_(gate));
                }
            }
        }
        wave_lds_fence();
    }
}
__device__ __forceinline__ void hgrn_pass1_old(const Ctx& C, int l, int item) {
    const int c = item & 31, hd = (item >> 5) & 3, b = (item >> 7) & 7, z = item >> 10;
    float* wl = (float*)(C.lds + C.wave * 12288);
    float S[64];
#pragma unroll
    for (int i = 0; i < 64; ++i) S[i] = 0.f;
    float decp = 1.f;
    hgrn_run<0>(C, l, z, b, hd, c, S, decp, wl, hgrn_lb(C, l, hd * 64 + C.lane));
    float* sb = C.fp(OFF_S) + (size_t)item * 4096;
#pragma unroll
    for (int i = 0; i < 64; ++i) sb[i * 64 + C.lane] = S[i];
    C.fp(OFF_DEC)[item * 64 + C.lane] = decp;
}
__device__ __forceinline__ void hgrn_pass3_old(const Ctx& C, int l, int item) {
    const int c = item & 31, hd = (item >> 5) & 3, b = item >> 7;
    float* wl = (float*)(C.lds + C.wave * 12288);
    const float lb = hgrn_lb(C, l, hd * 64 + C.lane);
    float S[64]; float decp = 1.f;
    {
        const int it1 = (((1 * 8 + b) * 4 + hd) * 32) + (31 - c);
        const float* sb = C.fp(OFF_S) + (size_t)it1 * 4096;
#pragma unroll
        for (int i = 0; i < 64; ++i) S[i] = sb[i * 64 + C.lane];
        hgrn_run<1>(C, l, 1, b, hd, 31 - c, S, decp, wl, lb);
    }
    __threadfence();
    {
        const int it0 = (((0 * 8 + b) * 4 + hd) * 32) + c;
        const float* sb = C.fp(OFF_S) + (size_t)it0 * 4096;
#pragma unroll
        for (int i = 0; i < 64; ++i) S[i] = sb[i * 64 + C.lane];
        hgrn_run<2>(C, l, 0, b, hd, c, S, decp, wl, lb);
    }
}
__device__ __forceinline__ void hgrn_scan(const Ctx& C) {
    float* Sb = C.fp(OFF_S); const float* dec = C.fp(OFF_DEC);
    for (int idx = C.bid * NTHR + C.tid; idx < 64 * 4096; idx += C.G * NTHR) {
        const int seq = idx >> 12, e = idx & 4095, i = e >> 6;
        float tv[32], dv[32];
#pragma unroll
        for (int c = 0; c < 32; ++c) { const size_t it = (size_t)seq * 32 + c; tv[c] = Sb[it * 4096 + e]; dv[c] = dec[it * 64 + i]; }
        float run = 0.f;
#pragma unroll
        for (int c = 0; c < 32; ++c) { const size_t it = (size_t)seq * 32 + c; Sb[it * 4096 + e] = run; run = dv[c] * run + tv[c]; }
    }
}

constexpr int XCP = 264;
template <bool FINAL>
__device__ __forceinline__ void lru_item(const Ctx& C, int l, int item) {
    const int b = item >> 6, c = item & 63, tid = C.tid, lane = C.lane, w = C.wave, fr = lane & 15, quad = lane >> 4;
    bf16_t* xc = (bf16_t*)C.lds;
    float* Al = (float*)(C.lds + 33792 + w * 6528); bf16_t* Ul = (bf16_t*)(Al + 16 * 68);
    bf16_t* H0 = (bf16_t*)(C.lds + 86016); bf16_t* H1 = H0 + 64 * 256;
    const bf16_t* pb = C.bfp(OFF_PROJB);
    const int n = w & 3, z = w >> 2;
    bf16x8 Bw[2][4][2];
#pragma unroll
        for (int ty = 0; ty < 2; ++ty)
#pragma unroll
            for (int ks = 0; ks < 2; ++ks) {
                const float* wp = (ty ? C.P->in[9] : C.P->in[7]) + ((size_t)((l * 2 + z) * 4 + n) * 64 + 32 * ks + 8 * quad) * 64 + fr;
                asm volatile("" : "+v"(wp));
                float f[4][8];
#pragma unroll
                for (int dt = 0; dt < 4; ++dt)
#pragma unroll
                    for (int e = 0; e < 8; ++e) f[dt][e] = wp[e * 64 + 16 * dt];
#pragma unroll
                for (int dt = 0; dt < 4; ++dt) {
                    union { bf16x8 v; unsigned u[4]; } t_; t_.u[0] = cvt_pk_bf16(f[dt][0], f[dt][1]); t_.u[1] = cvt_pk_bf16(f[dt][2], f[dt][3]); t_.u[2] = cvt_pk_bf16(f[dt][4], f[dt][5]); t_.u[3] = cvt_pk_bf16(f[dt][6], f[dt][7]); Bw[ty][dt][ks] = t_.v; }
                asm volatile("" ::: "memory");
            }
    {
        int ch = tid & 255; asm volatile("" : "+v"(ch)); const int hf = tid >> 8;
        const float w0 = C.P->in[5][(l * 4 + 0) * 256 + ch], w1 = C.P->in[5][(l * 4 + 1) * 256 + ch], w2 = C.P->in[5][(l * 4 + 2) * 256 + ch], w3 = C.P->in[5][(l * 4 + 3) * 256 + ch], cb = C.P->in[6][l * 256 + ch];
        const int tl0 = hf * 32, t0 = c * 64 + tl0;
        const bf16_t* colp = pb + (size_t)(b * SEQ) * 512 + ch;
        float xm2 = (t0 - 2 >= 0) ? bf2f(colp[(size_t)(t0 - 2) * 512]) : 0.f, xm1 = (t0 - 1 >= 0) ? bf2f(colp[(size_t)(t0 - 1) * 512]) : 0.f, x0 = bf2f(colp[(size_t)t0 * 512]);
#pragma unroll 1
        for (int k8 = 0; k8 < 4; ++k8) { float xn[8];
#pragma unroll
            for (int k = 0; k < 8; ++k) { const int t = t0 + k8 * 8 + k + 1; xn[k] = (t < SEQ) ? bf2f(colp[(size_t)t * 512]) : 0.f; }
#pragma unroll
            for (int k = 0; k < 8; ++k) { xc[(tl0 + k8 * 8 + k) * XCP + ch] = f2bf(cb + w0 * xm2 + w1 * xm1 + w2 * x0 + w3 * xn[k]); xm2 = xm1; xm1 = x0; x0 = xn[k]; } }
    }
    __syncthreads();
    {
        float bav[4], bxv[4], spv[4];
#pragma unroll
        for (int dt = 0; dt < 4; ++dt) { const int chd = n * 64 + 16 * dt + fr; bav[dt] = C.P->in[8][(l * 2 + z) * 256 + chd]; bxv[dt] = C.P->in[10][(l * 2 + z) * 256 + chd];
            const float lam = C.P->in[11][(l * 2 + z) * 256 + chd]; spv[dt] = (-lam > 15.f) ? -lam : log1pf(__expf(-lam)); }
        const size_t cidx = (size_t)((z * 8 + b) * 64 + c) * 256 + n * 64 + lane;
        float h = FINAL ? C.fp(OFF_CARH)[cidx] : 0.f, Ap = 1.f;
        bf16_t* Hz = z ? H1 : H0;
#pragma unroll 1
        for (int s4 = 0; s4 < 4; ++s4) { const int tt = z ? 3 - s4 : s4;
            const bf16_t* xrow = xc + (16 * tt + fr) * XCP + n * 64 + 8 * quad;
            const bf16x8 xa0 = *(const bf16x8*)xrow, xa1 = *(const bf16x8*)(xrow + 32);
#pragma unroll
            for (int dt = 0; dt < 4; ++dt) {
                f32x4 Da = {0.f, 0.f, 0.f, 0.f}, Dx = {0.f, 0.f, 0.f, 0.f};
                Da = __builtin_amdgcn_mfma_f32_16x16x32_bf16(xa0, Bw[0][dt][0], Da, 0, 0, 0); Da = __builtin_amdgcn_mfma_f32_16x16x32_bf16(xa1, Bw[0][dt][1], Da, 0, 0, 0);
                Dx = __builtin_amdgcn_mfma_f32_16x16x32_bf16(xa0, Bw[1][dt][0], Dx, 0, 0, 0); Dx = __builtin_amdgcn_mfma_f32_16x16x32_bf16(xa1, Bw[1][dt][1], Dx, 0, 0, 0);
#pragma unroll
                for (int r = 0; r < 4; ++r) { const int tloc = 4 * quad + r, d = 16 * dt + fr;
                    const float rg = sigmoidf_(Da[r] + bav[dt]), ig = sigmoidf_(Dx[r] + bxv[dt]), la = -8.0f * rg * spv[dt], a = __expf(la);
                    const float x = bf2f(xc[(16 * tt + tloc) * XCP + n * 64 + d]);
                    Al[tloc * 68 + d] = a; Ul[tloc * 68 + d] = f2bf(sqrtf(fmaxf(1.0f - a * a, 0.f)) * ig * x); }
            }
            wave_lds_fence();
#pragma unroll
            for (int j = 0; j < 16; ++j) { const int tloc = z ? 15 - j : j;
                const float a = Al[tloc * 68 + lane], u = bf2f(Ul[tloc * 68 + lane]);
                h = fmaf(a, h, u); Ap *= a;
                if (FINAL) Hz[(16 * tt + tloc) * 256 + n * 64 + lane] = f2bf(h); }
            wave_lds_fence();
        }
        if (!FINAL) { C.fp(OFF_CARA)[cidx] = Ap; C.fp(OFF_CARH)[cidx] = h; }
    }
    if (FINAL) {
        __syncthreads();
        int ch = tid & 255; asm volatile("" : "+v"(ch)); const int zz = tid >> 8;
        const bf16_t* gp = pb + (size_t)(b * SEQ + c * 64) * 512 + 256 + ch; bf16_t* yb = C.bfp(OFF_YB) + (size_t)(b * SEQ + c * 64) * 256 + ch;
#pragma unroll 1
        for (int k8 = 0; k8 < 4; ++k8) { bf16_t gv_[8];
#pragma unroll
            for (int k = 0; k < 8; ++k) gv_[k] = gp[(size_t)(zz * 32 + k8 * 8 + k) * 512];
#pragma unroll
            for (int k = 0; k < 8; ++k) { const int tl = zz * 32 + k8 * 8 + k; const float hs = bf2f(H0[tl * 256 + ch]) + bf2f(H1[tl * 256 + ch]);
                yb[(size_t)tl * 256] = f2bf(hs * geluf_(bf2f(gv_[k]))); } }
    }
    __syncthreads();
}
__device__ __forceinline__ void lru_scan(const Ctx& C) {
    float* ca = C.fp(OFF_CARA); float* chh = C.fp(OFF_CARH);
    if (C.tid < 16) for (int idx = C.bid * 16 + C.tid; idx < 4096; idx += C.G * 16) {
        const int ch = idx & 255, zb = idx >> 8, z = zb >> 3;
        float run = 0.f;
#pragma unroll 1
        for (int hh = 0; hh < 2; ++hh) {
            float av[32], hv[32];
#pragma unroll
            for (int k = 0; k < 32; ++k) { const int kk = hh * 32 + k, c = z ? 63 - kk : kk; const size_t i = (size_t)(zb * 64 + c) * 256 + ch; av[k] = ca[i]; hv[k] = chh[i]; }
#pragma unroll
            for (int k = 0; k < 32; ++k) { const int kk = hh * 32 + k, c = z ? 63 - kk : kk; const size_t i = (size_t)(zb * 64 + c) * 256 + ch; chh[i] = run; run = av[k] * run + hv[k]; }
        }
    }
}

__device__ __forceinline__ void hy_tr_item(const Ctx& C, int l, int item) {
    const int cb = item / 512, tb = item % 512, lane = C.lane, tok0 = tb * 64;
    bf16_t* tile = (bf16_t*)(C.lds + C.wave * 8960);
    const bf16_t* pc = C.bfp(OFF_PROJC);
    const bool first = (tok0 % SEQ) == 0, lastb = ((tok0 + 64) % SEQ) == 0;
#pragma unroll 1
    for (int r0 = 0; r0 < 66; r0 += 22) { bf16_t tv_[22];
#pragma unroll
        for (int q = 0; q < 22; ++q) { const int rr = r0 + q; bf16_t v = 0;
            if (!((rr == 0 && first) || (rr == 65 && lastb))) v = pc[(size_t)(tok0 - 1 + rr) * 768 + cb * 64 + lane];
            tv_[q] = v; }
#pragma unroll
        for (int q = 0; q < 22; ++q) tile[(r0 + q) * 66 + lane] = tv_[q]; }
    wave_lds_fence();
    bf16_t* uct = C.bfp(OFF_UCT);
    const float w0v = C.P->in[12][(l * 3 + 0) * 768 + cb * 64 + lane], w1v = C.P->in[12][(l * 3 + 1) * 768 + cb * 64 + lane], w2v = C.P->in[12][(l * 3 + 2) * 768 + cb * 64 + lane], bbv = C.P->in[13][l * 768 + cb * 64 + lane];
#pragma unroll 8
    for (int ch = 0; ch < 64; ++ch) { const int cch = cb * 64 + ch;
        const float w0 = __shfl(w0v, ch), w1 = __shfl(w1v, ch), w2 = __shfl(w2v, ch), bb = __shfl(bbv, ch);
        const float v = bb + w0 * bf2f(tile[lane * 66 + ch]) + w1 * bf2f(tile[(lane + 1) * 66 + ch]) + w2 * bf2f(tile[(lane + 2) * 66 + ch]);
        uct[(size_t)cch * M_TOK + tok0 + lane] = f2bf(v); }
    wave_lds_fence();
}
__device__ __forceinline__ void hy_out_tr_item(const Ctx& C, int item) {
    const int cb = item / 512, tb = item % 512, lane = C.lane, tok0 = tb * 64;
    bf16_t* tile = (bf16_t*)(C.lds + C.wave * 8704);
    const bf16_t* yct = C.bfp(OFF_YCT); bf16_t* yc = C.bfp(OFF_YC);
#pragma unroll 1
    for (int c0 = 0; c0 < 64; c0 += 16) { bf16_t tv_[16];
#pragma unroll
        for (int q = 0; q < 16; ++q) tv_[q] = yct[(size_t)(cb * 64 + c0 + q) * M_TOK + tok0 + lane];
#pragma unroll
        for (int q = 0; q < 16; ++q) tile[(c0 + q) * 66 + lane] = tv_[q]; }
    wave_lds_fence();
    for (int tl = 0; tl < 64; ++tl) yc[(size_t)(tok0 + tl) * 256 + cb * 64 + lane] = tile[lane * 66 + tl];
    wave_lds_fence();
}
constexpr int GLEN = 8704, GOFF = 4352, UP = 5128, URO = 4599;
__device__ __forceinline__ void hy_conv(const bf16_t* Gf0, const bf16_t* Gf1, const bf16_t* Ur, f32x16 (&acc)[4], int w, int lane) {
    const int i = lane & 31, h = lane >> 5, bb = (lane >> 2) & 7, jj = lane & 3;
    const int T0 = 96 + 512 * w;
#pragma unroll
    for (int mm = 0; mm < 4; ++mm)
#pragma unroll
        for (int r = 0; r < 16; ++r) acc[mm][r] = 0.f;
    const int P0 = GOFF + (T0 - 4192) + i - 8 * h - 7;
    const bf16_t* gp = ((P0 & 1) ? Gf1 : Gf0) + (P0 & ~1);
    const bf16_t* up = Ur + bb * UP + (URO - 7 - 8 * h + 32 * jj - 4192);
    int nit = 287; asm volatile("" : "+s"(nit));
    union AF { bf16x8 v; unsigned u[4]; };
    AF ac; bf16x8 bc[4];
    { const unsigned* g4 = (const unsigned*)gp; ac.u[0] = g4[0]; ac.u[1] = g4[1]; ac.u[2] = g4[2]; ac.u[3] = g4[3];
#pragma unroll
      for (int mm = 0; mm < 4; ++mm) bc[mm] = *(const bf16x8*)(up - 128 * mm); }
#pragma unroll 2
    for (int it = 0; it < nit; ++it) {
        const int itn = (it + 1 < nit) ? it + 1 : it;
        AF an; bf16x8 bn[4];
        { const unsigned* g4 = (const unsigned*)(gp + 16 * itn); an.u[0] = g4[0]; an.u[1] = g4[1]; an.u[2] = g4[2]; an.u[3] = g4[3];
#pragma unroll
          for (int mm = 0; mm < 4; ++mm) bn[mm] = *(const bf16x8*)(up + 16 * itn - 128 * mm); }
#pragma unroll
        for (int mm = 0; mm < 4; ++mm) acc[mm] = __builtin_amdgcn_mfma_f32_32x32x16_bf16(ac.v, bc[mm], acc[mm], 0, 0, 0);
        ac = an;
#pragma unroll
        for (int mm = 0; mm < 4; ++mm) bc[mm] = bn[mm];
    }
}
__device__ __forceinline__ unsigned rev16(unsigned x) { return (x >> 16) | (x << 16); }
__device__ __forceinline__ void hy_conv_item(const Ctx& C, int l, int c) {
    const int tid = C.tid, lane = C.lane, w = C.wave;
    bf16_t* G10 = (bf16_t*)C.lds; bf16_t* G11 = G10 + GLEN; bf16_t* G20 = G11 + GLEN; bf16_t* G21 = G20 + GLEN; bf16_t* U = G21 + GLEN;
    float* red = (float*)(C.lds + (size_t)(4 * GLEN + 8 * UP) * 2); float* w3s = red + 64;
    for (int i = tid; i < 2 * GLEN; i += NTHR) ((unsigned*)G10)[i] = 0u;
    if (tid < 256) { const int q = tid >> 6, j = tid & 63; const int col = (q >> 1) * 512 + (q & 1) * 256 + c; w3s[q * 64 + j] = C.P->in[19][((size_t)l * 64 + j) * 1024 + col]; }
    __syncthreads();
    float ss[4] = {0.f, 0.f, 0.f, 0.f};
    const float adelta = 3.0701134573253945f + (float)c * ((15.350567286626972f - 3.0701134573253945f) / 255.f);
    const float* hdn = C.fp(OFF_HDN);
    float* hft = (float*)U;
#pragma unroll 1
    for (int k = 0; k < 8; ++k) { const int t = tid + NTHR * k; const f32x4* hr = (const f32x4*)(hdn + (size_t)t * 64);
        float a0 = 0.f, a1 = 0.f, a2 = 0.f, a3 = 0.f;
#pragma unroll 1
        for (int j8 = 0; j8 < 16; j8 += 8) {
        f32x4 hrow[8];
#pragma unroll
        for (int j4 = 0; j4 < 8; ++j4) hrow[j4] = hr[j8 + j4];
#pragma unroll
        for (int jj4 = 0; jj4 < 8; ++jj4) { const f32x4 hv = hrow[jj4]; const int j4 = j8 + jj4;
            const f32x4 q0 = *(const f32x4*)(w3s + 4 * j4), q1 = *(const f32x4*)(w3s + 64 + 4 * j4), q2 = *(const f32x4*)(w3s + 128 + 4 * j4), q3 = *(const f32x4*)(w3s + 192 + 4 * j4);
            a0 += hv.x * q0.x + hv.y * q0.y + hv.z * q0.z + hv.w * q0.w; a1 += hv.x * q1.x + hv.y * q1.y + hv.z * q1.z + hv.w * q1.w;
            a2 += hv.x * q2.x + hv.y * q2.y + hv.z * q2.z + hv.w * q2.w; a3 += hv.x * q3.x + hv.y * q3.y + hv.z * q3.z + hv.w * q3.w; } }
        const float dec = __expf(-((float)t / 4095.f) * adelta);
        a0 *= dec; a1 *= dec; a2 *= dec; a3 *= dec;
        hft[t] = a0; hft[4096 + t] = a1; hft[8192 + t] = a2; hft[12288 + t] = a3;
        ss[0] += a0 * a0; ss[1] += a1 * a1; ss[2] += a2 * a2; ss[3] += a3 * a3; }
#pragma unroll
    for (int q = 0; q < 4; ++q) { const float s_ = wave_sum(ss[q]); if (lane == 0) red[w * 4 + q] = s_; }
    __syncthreads();
    float sc[4];
#pragma unroll
    for (int q = 0; q < 4; ++q) { float s_ = 0.f; for (int ww = 0; ww < 8; ++ww) s_ += red[ww * 4 + q]; sc[q] = rsqrtf(s_ + 1e-6f); }
#pragma unroll 1
    for (int k = 0; k < 8; ++k) { const int t = tid + NTHR * k;
        const float h0 = hft[t] * sc[0], h1 = hft[4096 + t] * sc[1], h2 = hft[8192 + t] * sc[2], h3 = hft[12288 + t] * sc[3];
        if (t == 0) { const bf16_t v1 = f2bf(h0 + h1 + C.P->in[20][(l * 2 + 0) * 256 + c]), v2 = f2bf(h2 + h3 + C.P->in[20][(l * 2 + 1) * 256 + c]);
            G10[GOFF] = v1; G11[GOFF - 1] = v1; G20[GOFF] = v2; G21[GOFF - 1] = v2; }
        else { const bf16_t f1 = f2bf(h0), b1 = f2bf(h1), f2 = f2bf(h2), b2 = f2bf(h3);
            G10[GOFF + t] = f1; G11[GOFF + t - 1] = f1; G10[GOFF - t] = b1; G11[GOFF - t - 1] = b1;
            G20[GOFF + t] = f2; G21[GOFF + t - 1] = f2; G20[GOFF - t] = b2; G21[GOFF - t - 1] = b2; } }
    __syncthreads();
    for (int i = tid; i < 8 * UP / 2; i += NTHR) ((unsigned*)U)[i] = 0u;
    __syncthreads();
    bf16_t* uct = C.bfp(OFF_UCT);
    const bf16_t* vsrc = uct + (size_t)c * M_TOK; const bf16_t* x1src = uct + (size_t)(256 + c) * M_TOK; const bf16_t* x2src = uct + (size_t)(512 + c) * M_TOK;
    {
        u32x4 vin[8];
#pragma unroll
        for (int k = 0; k < 8; ++k) { const int id = tid + NTHR * k, bb_ = id >> 9, off = (id & 511) * 8; vin[k] = *(const u32x4*)(vsrc + (size_t)bb_ * SEQ + off); }
#pragma unroll
        for (int k = 0; k < 8; ++k) { const int id = tid + NTHR * k, bb_ = id >> 9, off = (id & 511) * 8;
            u32x4 o; o.x = rev16(vin[k].w); o.y = rev16(vin[k].z); o.z = rev16(vin[k].y); o.w = rev16(vin[k].x);
            *(u32x4*)(U + bb_ * UP + (URO - 7 - off)) = o; }
    }
    __syncthreads();
    f32x16 acc[4];
    const int h = lane >> 5, bb = (lane >> 2) & 7, jj = lane & 3;
    hy_conv(G10, G11, U, acc, w, lane);
    __syncthreads();
    u32x2 xall[4][4];
#pragma unroll
    for (int mm = 0; mm < 4; ++mm)
#pragma unroll
        for (int k4 = 0; k4 < 4; ++k4) { const int t = 96 + 512 * w + 128 * mm - 32 * jj + 8 * k4 + 4 * h; xall[mm][k4] = *(const u32x2*)(x1src + (size_t)bb * SEQ + t); }
#pragma unroll
    for (int mm = 0; mm < 4; ++mm)
#pragma unroll
        for (int k4 = 0; k4 < 4; ++k4) { const int t = 96 + 512 * w + 128 * mm - 32 * jj + 8 * k4 + 4 * h;
            const u32x2 xv = xall[mm][k4];
            u32x2 o; o.x = cvt_pk_bf16(acc[mm][4 * k4 + 3] * bfhi(xv.y), acc[mm][4 * k4 + 2] * bflo(xv.y)); o.y = cvt_pk_bf16(acc[mm][4 * k4 + 1] * bfhi(xv.x), acc[mm][4 * k4] * bflo(xv.x));
            *(u32x2*)(U + bb * UP + (URO - 3 - t)) = o; }
    __syncthreads();
    hy_conv(G20, G21, U, acc, w, lane);
    bf16_t* ydst = C.bfp(OFF_YCT) + (size_t)c * M_TOK;
#pragma unroll
    for (int mm = 0; mm < 4; ++mm)
#pragma unroll
        for (int k4 = 0; k4 < 4; ++k4) { const int t = 96 + 512 * w + 128 * mm - 32 * jj + 8 * k4 + 4 * h; xall[mm][k4] = *(const u32x2*)(x2src + (size_t)bb * SEQ + t); }
#pragma unroll
    for (int mm = 0; mm < 4; ++mm)
#pragma unroll
        for (int k4 = 0; k4 < 4; ++k4) { const int t = 96 + 512 * w + 128 * mm - 32 * jj + 8 * k4 + 4 * h;
            const u32x2 xv = xall[mm][k4];
            u32x2 o; o.x = cvt_pk_bf16(acc[mm][4 * k4] * bflo(xv.x), acc[mm][4 * k4 + 1] * bfhi(xv.x)); o.y = cvt_pk_bf16(acc[mm][4 * k4 + 2] * bflo(xv.y), acc[mm][4 * k4 + 3] * bfhi(xv.y));
            *(u32x2*)(ydst + (size_t)bb * SEQ + t) = o; }
    __syncthreads();
}

__device__ __forceinline__ void attn_fetch(const Ctx& C, int it, u32x4 (&kv)[4], u32x4 (&vv)[4], u32x4 (&qv)[2]) {
    const int tid = C.tid;
    const int b = it / 384, rem = it % 384, hq = rem >> 5, kk = rem & 31, g = hq >> 2, dil = 1 << (2 * g), n = SEQ / dil, nblk = 32 / dil, r = kk / nblk, jb = kk % nblk;
    const bf16_t* pd = C.bfp(OFF_PROJD);
#pragma unroll
    for (int k = 0; k < 4; ++k) { const int id = tid + NTHR * k, cidx = id >> 3, ch = id & 7, ik = 128 * jb - 64 + cidx;
        kv[k] = (u32x4){0u, 0u, 0u, 0u}; vv[k] = (u32x4){0u, 0u, 0u, 0u};
        if (ik >= 0 && ik < n) { const bf16_t* row = pd + (size_t)(b * SEQ + r + dil * ik) * 2304; kv[k] = *(const u32x4*)(row + 768 + hq * 64 + ch * 8); vv[k] = *(const u32x4*)(row + 1536 + hq * 64 + ch * 8); } }
#pragma unroll
    for (int k = 0; k < 2; ++k) { const int id = tid + NTHR * k, a = id >> 3, ch = id & 7;
        qv[k] = *(const u32x4*)(pd + (size_t)(b * SEQ + r + dil * (128 * jb + a)) * 2304 + hq * 64 + ch * 8); }
}
__device__ __forceinline__ void attn_item(const Ctx& C, int it, int itn, u32x4 (&kv)[4], u32x4 (&vv)[4], u32x4 (&qv)[2]) {
    const int tid = C.tid, lane = C.lane, w = C.wave;
    const int b = it / 384, rem = it % 384, hq = rem >> 5, kk = rem & 31, g = hq >> 2, dil = 1 << (2 * g), n = SEQ / dil, nblk = 32 / dil, r = kk / nblk, jb = kk % nblk;
    bf16_t* Ks = (bf16_t*)C.lds; bf16_t* Qs = Ks + 256 * 72; bf16_t* Vs = Qs + 128 * 72; float* bt = (float*)(Vs + 256 * 72);
    bf16_t* pd = C.bfp(OFF_PROJD);
    if (tid < 129) { const int rel = (tid - 64) * dil, na = rel < 0 ? -rel : rel;
        int bk = na < 8 ? na : 8 + (na >= 15) + (na >= 27) + (na >= 50) + (na >= 91) + (na >= 166) + (na >= 305) + (na >= 559);
        if (rel > 0) bk += 16;
        bt[tid] = C.P->in[21][bk * 12 + hq]; }
    {
#pragma unroll
        for (int k = 0; k < 4; ++k) { const int id = tid + NTHR * k, cidx = id >> 3, ch = id & 7;
            *(u32x4*)(Ks + cidx * 72 + ch * 8) = kv[k];
            *(u32x4*)(Vs + cidx * 72 + ch * 8) = vv[k]; }
#pragma unroll
        for (int k = 0; k < 2; ++k) { const int id = tid + NTHR * k, a = id >> 3, ch = id & 7; *(u32x4*)(Qs + a * 72 + ch * 8) = qv[k]; }
    }
    if (itn < 3072) attn_fetch(C, itn, kv, vv, qv);
    __syncthreads();
    const int fr = lane & 15, quad = lane >> 4;
    bf16x8 qf[2];
    qf[0] = *(const bf16x8*)(Qs + (16 * w + fr) * 72 + 8 * quad); qf[1] = *(const bf16x8*)(Qs + (16 * w + fr) * 72 + 32 + 8 * quad);
    f32x4 sc[9];
#pragma unroll
    for (int kt = 0; kt < 9; ++kt) { const bf16_t* kr = Ks + (16 * (w + kt) + fr) * 72 + 8 * quad;
        const bf16x8 k0 = *(const bf16x8*)kr, k1 = *(const bf16x8*)(kr + 32);
        f32x4 z4 = {0.f, 0.f, 0.f, 0.f};
        z4 = __builtin_amdgcn_mfma_f32_16x16x32_bf16(k0, qf[0], z4, 0, 0, 0);
        sc[kt] = __builtin_amdgcn_mfma_f32_16x16x32_bf16(k1, qf[1], z4, 0, 0, 0); }
    const int a = 16 * w + fr;
    float mx = -1e30f;
#pragma unroll
    for (int kt = 0; kt < 9; ++kt)
#pragma unroll
        for (int rg = 0; rg < 4; ++rg) { const int cidx = 16 * (w + kt) + 4 * quad + rg, rel = cidx - 64 - a, ik = 128 * jb - 64 + cidx;
            const bool valid = (rel >= -64) && (rel <= 64) && (ik >= 0) && (ik < n);
            const int bi = rel < -64 ? 0 : (rel > 64 ? 128 : rel + 64);
            const float s = valid ? sc[kt][rg] * 0.125f + bt[bi] : -1e30f;
            sc[kt][rg] = s; mx = fmaxf(mx, s); }
    mx = fmaxf(mx, __shfl_xor(mx, 16)); mx = fmaxf(mx, __shfl_xor(mx, 32));
    float lsum = 0.f;
#pragma unroll
    for (int kt = 0; kt < 9; ++kt)
#pragma unroll
        for (int rg = 0; rg < 4; ++rg) { const float s = sc[kt][rg]; const float p = (s > -1e29f) ? __expf(s - mx) : 0.f; sc[kt][rg] = p; lsum += p; }
    lsum += __shfl_xor(lsum, 16); lsum += __shfl_xor(lsum, 32);
    f32x4 oo[4];
#pragma unroll
    for (int dt = 0; dt < 4; ++dt) oo[dt] = (f32x4){0.f, 0.f, 0.f, 0.f};
#pragma unroll
    for (int pp = 0; pp < 5; ++pp) { const int ktA = 2 * pp, ktB = 2 * pp + 1, ktBc = ktB < 9 ? ktB : 8;
        union { bf16x8 v; unsigned u[4]; } pf;
        pf.u[0] = cvt_pk_bf16(sc[ktA][0], sc[ktA][1]); pf.u[1] = cvt_pk_bf16(sc[ktA][2], sc[ktA][3]);
        if (ktB < 9) { pf.u[2] = cvt_pk_bf16(sc[ktBc][0], sc[ktBc][1]); pf.u[3] = cvt_pk_bf16(sc[ktBc][2], sc[ktBc][3]); } else { pf.u[2] = 0u; pf.u[3] = 0u; }
#pragma unroll
        for (int dt = 0; dt < 4; ++dt) { const bf16_t* vr = Vs + (16 * w + 4 * quad + (fr >> 2)) * 72 + 16 * dt + 4 * (fr & 3);
            union { bf16x8 v; s16x4_t h[2]; } vf; vf.h[0] = lds_tr_b64(vr + 16 * ktA * 72); vf.h[1] = lds_tr_b64(vr + 16 * ktBc * 72);
            oo[dt] = __builtin_amdgcn_mfma_f32_16x16x32_bf16(vf.v, pf.v, oo[dt], 0, 0, 0); } }
    const float inv = 1.0f / lsum;
    const size_t tok = (size_t)(b * SEQ + r + dil * (128 * jb + a));
    __syncthreads();
#pragma unroll
    for (int dt = 0; dt < 4; ++dt) { u32x2 o; o.x = cvt_pk_bf16(oo[dt][0] * inv, oo[dt][1] * inv); o.y = cvt_pk_bf16(oo[dt][2] * inv, oo[dt][3] * inv);
        *(u32x2*)(pd + tok * 2304 + hq * 64 + 16 * dt + 4 * quad) = o; }
    if (quad == 0) C.fp(OFF_LSE)[((size_t)g * M_TOK + tok) * 4 + (hq & 3)] = mx + __logf(lsum);
}
__device__ __forceinline__ void attn_combine(const Ctx& C) {
    const bf16_t* pd = C.bfp(OFF_PROJD); const float* lse = C.fp(OFF_LSE); bf16_t* yd = C.bfp(OFF_YD);
    for (int idx = C.bid * NTHR + C.tid; idx < M_TOK * 32; idx += C.G * NTHR) {
        const int tok = idx >> 5, j = (idx >> 3) & 3, c8 = idx & 7;
        const float l0 = lse[((size_t)0 * M_TOK + tok) * 4 + j], l1 = lse[((size_t)1 * M_TOK + tok) * 4 + j], l2 = lse[((size_t)2 * M_TOK + tok) * 4 + j];
        const float mx = fmaxf(l0, fmaxf(l1, l2)); float w0 = __expf(l0 - mx), w1 = __expf(l1 - mx), w2 = __expf(l2 - mx); const float inv = 1.0f / (w0 + w1 + w2); w0 *= inv; w1 *= inv; w2 *= inv;
        const bf16_t* row = pd + (size_t)tok * 2304 + j * 64 + c8 * 8;
        const u32x4 o0 = *(const u32x4*)row, o1 = *(const u32x4*)(row + 256), o2 = *(const u32x4*)(row + 512);
        u32x4 o;
        o.x = cvt_pk_bf16(w0 * bflo(o0.x) + w1 * bflo(o1.x) + w2 * bflo(o2.x), w0 * bfhi(o0.x) + w1 * bfhi(o1.x) + w2 * bfhi(o2.x));
        o.y = cvt_pk_bf16(w0 * bflo(o0.y) + w1 * bflo(o1.y) + w2 * bflo(o2.y), w0 * bfhi(o0.y) + w1 * bfhi(o1.y) + w2 * bfhi(o2.y));
        o.z = cvt_pk_bf16(w0 * bflo(o0.z) + w1 * bflo(o1.z) + w2 * bflo(o2.z), w0 * bfhi(o0.z) + w1 * bfhi(o1.z) + w2 * bfhi(o2.z));
        o.w = cvt_pk_bf16(w0 * bflo(o0.w) + w1 * bflo(o1.w) + w2 * bflo(o2.w), w0 * bfhi(o0.w) + w1 * bfhi(o1.w) + w2 * bfhi(o2.w));
        *(u32x4*)(yd + (size_t)tok * 256 + j * 64 + c8 * 8) = o;
    }
}

__global__ void __launch_bounds__(NTHR, 2) fwd_megakernel(Params prm) {
    extern __shared__ __attribute__((aligned(16))) unsigned char shm[];
    cg::grid_group grid = cg::this_grid();
    Ctx C;
    C.P = &prm;
    C.out = prm.out; C.ws = prm.ws; C.bid = blockIdx.x; C.G = gridDim.x; C.lds = shm;
#define FRESH() do { int _t = threadIdx.x; asm volatile("" : "+v"(_t)); C.tid = _t; C.lane = _t & 63; C.wave = __builtin_amdgcn_readfirstlane(_t >> 6); size_t _z = 0; asm volatile("" : "+s"(_z)); C.ws = prm.ws + _z; C.out = prm.out + _z; } while (0)
    FRESH();
    LAS unsigned char* ldsg = (LAS unsigned char*)shm;
    volatile LAS unsigned* xst = (volatile LAS unsigned*)(ldsg + (LDS_BYTES - 16));
    if (threadIdx.x == 0) { xst[0] = 0u; xst[1] = 0u; }
    __syncthreads();
    const XcdBarrier xbar = xcd_barrier_post((unsigned*)(prm.ws + OFF_BAR), xst);
#define GSYNC() do { xcd_barrier(xbar); FRESH(); } while (0)
    const int G = C.G, bid = C.bid;

    for (int l = 0; l < 2; ++l) {
        const float* xin = (l == 0) ? C.P->in[0] : C.out;
        FRESH();
        for (int _m = 0; _m < REP_MIXC; ++_m) phase_p0(C, l, xin);
        if (l == 0) { grid.sync(); FRESH(); } else GSYNC();
        for (int _g = 0; _g < REP_GEMM; ++_g) { pg8::Gemm g{C.bfp(OFF_H), C.bfp(OFF_WIN), M_TOK, INW, 1024}; pg8::StaticOrder S; S.init(M_TOK, INW, G, bid);
          pg8::EpiProj E{C.bfp(OFF_PROJA), C.bfp(OFF_PROJB), C.bfp(OFF_PROJC), C.bfp(OFF_PROJD)};
          pg8::gemm_phase<pg8::EpiProj, pg8::StaticOrder, true, true>(ldsg, g, S, E); }
        {
            const int tc = 2432 % G; const bool all = (tc == 0);
            if (all || bid >= tc) { FRESH(); const int nwk = all ? G : G - tc, idx = all ? bid : bid - tc;
                for (int t = idx * 8 + C.wave; t < 4096; t += nwk * 8)
                    hy_hdn_row(C.P->in[14] + (size_t)l * 33 * 64, C.P->in[15] + l * 64, C.P->in[16] + l * 64, C.P->in[17] + (size_t)l * 64 * 64, C.P->in[18] + l * 64, C.fp(OFF_HDN), t, C.lane); }
        }
        GSYNC();
        FRESH();
        { u32x4 akv[4], avv[4], aqv[2]; attn_fetch(C, bid, akv, avv, aqv);
          for (int it = bid; it < 3072; it += G) attn_item(C, it, it + G, akv, avv, aqv); }
        __syncthreads();
        FRESH();
        for (int _m = 0; _m < REP_MIXA; ++_m) for (int it = bid; it < 512; it += G) lru_item<false>(C, l, it);
        FRESH();
        for (int _m = 0; _m < REP_MIXB; ++_m) for (int it = bid * 8 + C.wave; it < 2048; it += G * 8) hgrn_pass1_item(C, l, it);
        __syncthreads();
        FRESH();
        for (int _m = 0; _m < REP_MIXC; ++_m) for (int it = bid * 8 + C.wave; it < 6144; it += G * 8) hy_tr_item(C, l, it);
        GSYNC();
        FRESH();
        hgrn_scan(C); lru_scan(C);
        GSYNC();
        FRESH();
        for (int _m = 0; _m < REP_HYC; ++_m) for (int c = bid; c < 256; c += G) hy_conv_item(C, l, c);
        __syncthreads();
        FRESH();
        for (int _m = 0; _m < REP_MIXB; ++_m) for (int it = bid * 8 + C.wave; it < 1024; it += G * 8) hgrn_pass3_item<1>(C, l, it);
        __syncthreads();
        FRESH();
        for (int _m = 0; _m < REP_MIXA; ++_m) for (int it = bid; it < 512; it += G) lru_item<true>(C, l, it);
        GSYNC();
        FRESH();
        for (int it = bid * 8 + C.wave; it < 1024; it += G * 8) hgrn_pass3_item<0>(C, l, it);
        __syncthreads();
        for (int _m = 0; _m < REP_MIXC; ++_m) { for (int it = bid * 8 + C.wave; it < 2048; it += G * 8) hy_out_tr_item(C, it);
        FRESH();
        attn_combine(C); }
        GSYNC();
        for (int _g = 0; _g < REP_GEMM; ++_g) for (int j = 0; j < 4; ++j) {
            const bf16_t* yj = (j == 0) ? C.bfp(OFF_YA) : (j == 1) ? C.bfp(OFF_YB) : (j == 2) ? C.bfp(OFF_YC) : C.bfp(OFF_YD);
            pg8::Gemm g{yj, C.bfp(OFF_WBR) + (size_t)j * 1024 * 256, M_TOK, 1024, 256}; pg8::StaticOrder S; S.init(M_TOK, 1024, G, bid);
            pg8::EpiBf16 E{C.bfp(OFF_P) + j * 1024, 4096};
            pg8::gemm_phase(ldsg, g, S, E);
        }
        GSYNC();
        for (int _g = 0; _g < REP_GEMM; ++_g) { pg8::Gemm g{C.bfp(OFF_H), C.bfp(OFF_WGATE), M_TOK, 4096, 1024}; pg8::GateOrder S{G, bid};
          pg8::EpiGate E{C.bfp(OFF_P), C.bfp(OFF_MIXED), C.P->in[24] + (size_t)l * 4096};
          pg8::gemm_phase<pg8::EpiGate, pg8::GateOrder, true, true>(ldsg, g, S, E); }
        GSYNC();
        { pg8::Gemm g{C.bfp(OFF_MIXED), C.bfp(OFF_WOUT), M_TOK, 1024, 1024}; pg8::StaticOrder S; S.init(M_TOK, 1024, G, bid);
          pg8::EpiRes E{xin, C.out};
          pg8::gemm_phase<pg8::EpiRes, pg8::StaticOrder, true, true>(ldsg, g, S, E); }
        GSYNC();
        FRESH();
        for (int row = bid * 8 + C.wave; row < M_TOK; row += 2 * G * 8) rms_row2_bf16(C.out + (size_t)row * 1024, (size_t)G * 8 * 1024, C.P->in[26] + l * 1024, C.bfp(OFF_H) + (size_t)row * 1024, C.lane);
        GSYNC();
        for (int _g = 0; _g < REP_GEMM; ++_g) { pg8::Gemm g{C.bfp(OFF_H), C.bfp(OFF_WFF13), M_TOK, 2 * DFF, 1024}; pg8::StaticOrder S; S.init(M_TOK, 2 * DFF, G, bid);
          pg8::EpiSwiglu E{C.bfp(OFF_U)};
          pg8::gemm_phase<pg8::EpiSwiglu, pg8::StaticOrder, true, true>(ldsg, g, S, E); }
        GSYNC();
        { pg8::Gemm g{C.bfp(OFF_U), C.bfp(OFF_WFF2), M_TOK, 1024, DFF}; pg8::StaticOrder S; S.init(M_TOK, 1024, G, bid);
          pg8::EpiRes E{C.out, C.out};
          pg8::gemm_phase<pg8::EpiRes, pg8::StaticOrder, true, true>(ldsg, g, S, E); }
        GSYNC();
    }
    FRESH();
    for (int row = bid * 8 + C.wave; row < M_TOK; row += G * 8) rms_row_f32(C.out + (size_t)row * 1024, C.P->in[30], C.lane);
}

extern "C" void kernel_launch(void* const* d_in, const int* in_sizes, int n_in, void* d_out, int out_size, void* d_ws, size_t ws_size, hipStream_t stream) {
    static int grid_blocks = 0;
    if (!grid_blocks) {
        if (n_in != 31 || ws_size < WS_END) { fprintf(stderr, "kernel_launch: unexpected n_in %d or ws_size %zu (< %zu)\n", n_in, ws_size, (size_t)WS_END); }
        int dev = 0, cus = 0, per_cu = 0;
        hipGetDevice(&dev);
        hipDeviceGetAttribute(&cus, hipDeviceAttributeMultiprocessorCount, dev);
        hipFuncSetAttribute((const void*)fwd_megakernel, hipFuncAttributeMaxDynamicSharedMemorySize, LDS_BYTES);
        hipOccupancyMaxActiveBlocksPerMultiprocessor(&per_cu, (const void*)fwd_megakernel, NTHR, LDS_BYTES);
        if (per_cu < 1) per_cu = 1;
        grid_blocks = cus * per_cu;
        (void)hipGetLastError();
    }
    Params p{};
    for (int i = 0; i < 31; ++i) p.in[i] = (const float*)d_in[i];
    p.out = (float*)d_out; p.ws = (unsigned char*)d_ws;
    hipMemsetAsync((unsigned char*)d_ws + OFF_BAR, 0, 16384, stream);
    void* args[] = {&p};
    hipError_t e = hipLaunchCooperativeKernel((const void*)fwd_megakernel, dim3(grid_blocks), dim3(NTHR), args, LDS_BYTES, stream);
    if (e != hipSuccess) fprintf(stderr, "cooperative launch failed: %s (grid %d)\n", hipGetErrorString(e), grid_blocks);
}
```
